# Optimizing an MI355X kernel written in HIP

```python
import math
import jax, jax.numpy as jnp
from jax import lax
import numpy as np

D_MODEL = 1024
BATCH = 4
SEQ = 4096
DEPTH = 1

ATTN_HEADS = 4
QK_DIM = 64
V_DIM = 2 * QK_DIM
ATTN_WIDTH = ATTN_HEADS * V_DIM
ROPE_DIM = QK_DIM // 4
ROPE_THETA = 500000.0
Q_BLOCK = 128
HYENA_WIDTH = D_MODEL // 2
HYENA_ORDER = 2
FILTER_BANDS = 16
FILTER_EMB = 2 * FILTER_BANDS + 1
FILTER_HIDDEN = 64
DECAY_TARGET = 1e-2
FAST_DECAY_PCT = 0.3
SLOW_DECAY_PCT = 1.5
Q_COLS = ATTN_HEADS * 2 * QK_DIM
K_COLS = ATTN_HEADS * 2 * QK_DIM
V_COLS = ATTN_WIDTH
HY_COLS = (HYENA_ORDER + 1) * HYENA_WIDTH
GATE_COLS = 2 * D_MODEL
IN_COLS = Q_COLS + K_COLS + V_COLS + HY_COLS + GATE_COLS
N_EXPERTS = 16
CAPACITY_FACTOR = 2
EXPERT_HIDDEN = 1024
EPS = 1e-6

kernel_name = "hybrid_diffattn_hyena_ecmoe_block"


def rms_norm(x, g):
    xf = x.astype(jnp.float32)
    y = xf * lax.rsqrt(jnp.mean(xf * xf, axis=-1, keepdims=True) + EPS)
    return (y * g.astype(jnp.float32)).astype(x.dtype)


def rope_partial(t, cos, sin):
    half = ROPE_DIM // 2
    r1 = t[..., :half]
    r2 = t[..., half:ROPE_DIM]
    rot = jnp.concatenate([r1 * cos - r2 * sin, r2 * cos + r1 * sin], axis=-1)
    return jnp.concatenate([rot.astype(t.dtype), t[..., ROPE_DIM:]], axis=-1)


def diff_attention(q, k, v, lam, subln_g, lambda_init):
    b, h, _, l, dk = q.shape
    nb = l // Q_BLOCK
    scale = 1.0 / math.sqrt(dk)
    qb = q.reshape(b, h, 2, nb, Q_BLOCK, dk).transpose(3, 0, 1, 2, 4, 5)

    def block(qi):
        s = jnp.einsum('bhmqd,bhmkd->bhmqk', qi, k).astype(jnp.float32) * scale
        pr = jax.nn.softmax(s, axis=-1)
        a = pr[:, :, 0] - lam * pr[:, :, 1]
        return jnp.einsum('bhqk,bhkd->bhqd', a.astype(v.dtype), v)

    o = lax.map(block, qb)
    o = o.transpose(1, 2, 0, 3, 4).reshape(b, h, l, V_DIM)
    o = rms_norm(o, subln_g) * (1.0 - lambda_init)
    return o.transpose(0, 2, 1, 3).reshape(b, l, h * V_DIM)


def hyena_filter_spectra(l, w1, b1, w2, b2, w3, b3, w_out, freq):
    f32 = jnp.float32
    pos = jnp.arange(l, dtype=f32)
    t = pos / max(l - 1, 1)
    bands = jnp.linspace(1e-4, FILTER_BANDS - 1, FILTER_BANDS, dtype=f32)
    ang = (2.0 * math.pi / l) * pos[:, None] * bands[None, :]
    emb = jnp.concatenate([t[:, None], jnp.cos(ang), -jnp.sin(ang)], axis=-1)
    fr = freq.astype(f32)
    hid = jnp.sin(fr * (emb @ w1.astype(f32) + b1.astype(f32)))
    hid = jnp.sin(fr * (hid @ w2.astype(f32) + b2.astype(f32)))
    hid = jnp.sin(fr * (hid @ w3.astype(f32) + b3.astype(f32)))
    filt = (hid @ w_out.astype(f32)).reshape(l, HYENA_ORDER, 2, HYENA_WIDTH)
    min_decay = math.log(DECAY_TARGET) / SLOW_DECAY_PCT
    max_decay = math.log(DECAY_TARGET) / FAST_DECAY_PCT
    deltas = jnp.abs(jnp.linspace(min_decay, max_decay, HYENA_WIDTH, dtype=f32))
    filt = filt * jnp.exp(-t[:, None] * deltas[None, :])[:, None, None, :]
    kern = jnp.concatenate([filt[:, :, 0],
                            jnp.zeros((1, HYENA_ORDER, HYENA_WIDTH), f32),
                            filt[:0:-1, :, 1]], axis=0)
    return jnp.fft.rfft(kern, axis=0)


def long_conv(z, spec):
    l = z.shape[1]
    zf = jnp.fft.rfft(z.astype(jnp.float32), n=2 * l, axis=1)
    y = jnp.fft.irfft(zf * spec[None], n=2 * l, axis=1)[:, :l]
    return y.astype(z.dtype)


def short_conv(z, w, b):
    zp = jnp.pad(z, ((0, 0), (1, 1), (0, 0)))
    return zp[:, :-2] * w[0] + zp[:, 1:-1] * w[1] + zp[:, 2:] * w[2] + b


def hyena_mixer(hy, conv_w, conv_b, spec, skip):
    hy = short_conv(hy, conv_w, conv_b)
    z, g1, g2 = jnp.split(hy, HYENA_ORDER + 1, axis=-1)
    gates = (g1, g2)
    for n in range(HYENA_ORDER):
        z = gates[n] * (long_conv(z, spec[:, n]) + skip[n] * z)
    return z


def expert_choice_ffn(u, w_router, w_gate, w_up, w_down):
    b, l, d = u.shape
    cap = CAPACITY_FACTOR * l // N_EXPERTS
    logits = jnp.einsum('bld,de->ble', u, w_router).astype(jnp.float32)
    aff = jax.nn.softmax(logits, axis=-1)
    g, idx = lax.top_k(aff.transpose(0, 2, 1), cap)
    xin = jax.vmap(lambda ub, ib: ub[ib])(u, idx)
    hg = jnp.einsum('becd,edf->becf', xin, w_gate)
    hu = jnp.einsum('becd,edf->becf', xin, w_up)
    eo = jnp.einsum('becf,efd->becd', jax.nn.silu(hg) * hu, w_down)
    weighted = eo * g[..., None].astype(eo.dtype)
    return jax.vmap(lambda ib, wb: jnp.zeros((l, d), wb.dtype).at[ib.reshape(-1)].add(wb.reshape(-1, d)))(idx, weighted)


def setup_inputs(seed: int = 0) -> dict:
    key = jax.random.key(seed)
    ks = iter(jax.random.split(key, 32))

    def nrm(shape, std):
        return jax.random.normal(next(ks), shape, jnp.float32) * std

    def gain(shape):
        return 1.0 + nrm(shape, 0.02)

    L_ = DEPTH
    return {
        "x": nrm((BATCH, SEQ, D_MODEL), 1.0),
        "norm1_g": gain((L_, D_MODEL)),
        "w_in": nrm((L_, D_MODEL, IN_COLS), D_MODEL ** -0.5),
        "short_conv_w": nrm((L_, 3, HY_COLS), 3 ** -0.5),
        "short_conv_b": nrm((L_, HY_COLS), 0.01),
        "q_norm_g": gain((L_, QK_DIM)),
        "k_norm_g": gain((L_, QK_DIM)),
        "lambda_q1": nrm((L_, QK_DIM), 0.1),
        "lambda_k1": nrm((L_, QK_DIM), 0.1),
        "lambda_q2": nrm((L_, QK_DIM), 0.1),
        "lambda_k2": nrm((L_, QK_DIM), 0.1),
        "subln_g": gain((L_, V_DIM)),
        "filt_w1": nrm((L_, FILTER_EMB, FILTER_HIDDEN), FILTER_EMB ** -0.5),
        "filt_b1": nrm((L_, FILTER_HIDDEN), 0.01),
        "filt_w2": nrm((L_, FILTER_HIDDEN, FILTER_HIDDEN), FILTER_HIDDEN ** -0.5),
        "filt_b2": nrm((L_, FILTER_HIDDEN), 0.01),
        "filt_w3": nrm((L_, FILTER_HIDDEN, FILTER_HIDDEN), FILTER_HIDDEN ** -0.5),
        "filt_b3": nrm((L_, FILTER_HIDDEN), 0.01),
        "filt_w_out": nrm((L_, FILTER_HIDDEN, HYENA_ORDER * 2 * HYENA_WIDTH), 0.003),
        "filt_freq": 1.0 + nrm((L_, FILTER_HIDDEN), 0.1),
        "hyena_skip": nrm((L_, HYENA_ORDER, HYENA_WIDTH), 0.5),
        "w_branch_attn": nrm((L_, ATTN_WIDTH, D_MODEL), ATTN_WIDTH ** -0.5),
        "w_branch_hyena": nrm((L_, HYENA_WIDTH, D_MODEL), HYENA_WIDTH ** -0.5),
        "w_out": nrm((L_, D_MODEL, D_MODEL), D_MODEL ** -0.5),
        "norm2_g": gain((L_, D_MODEL)),
        "w_router": nrm((L_, D_MODEL, N_EXPERTS), D_MODEL ** -0.5),
        "w_gate": nrm((L_, N_EXPERTS, D_MODEL, EXPERT_HIDDEN), D_MODEL ** -0.5),
        "w_up": nrm((L_, N_EXPERTS, D_MODEL, EXPERT_HIDDEN), D_MODEL ** -0.5),
        "w_down": nrm((L_, N_EXPERTS, EXPERT_HIDDEN, D_MODEL), EXPERT_HIDDEN ** -0.5),
    }


def reference(x, norm1_g, w_in, short_conv_w, short_conv_b, q_norm_g, k_norm_g,
              lambda_q1, lambda_k1, lambda_q2, lambda_k2, subln_g,
              filt_w1, filt_b1, filt_w2, filt_b2, filt_w3, filt_b3, filt_w_out, filt_freq,
              hyena_skip, w_branch_attn, w_branch_hyena, w_out, norm2_g,
              w_router, w_gate, w_up, w_down):
    b, l, _ = x.shape
    pos = jnp.arange(l, dtype=jnp.float32)
    inv_freq = ROPE_THETA ** (-jnp.arange(0, ROPE_DIM, 2, dtype=jnp.float32) / ROPE_DIM)
    ang = pos[:, None] * inv_freq[None, :]
    cos, sin = jnp.cos(ang), jnp.sin(ang)
    splits = [Q_COLS, Q_COLS + K_COLS, Q_COLS + K_COLS + V_COLS,
              Q_COLS + K_COLS + V_COLS + HY_COLS]

    for li in range(DEPTH):
        lambda_init = 0.8 - 0.6 * math.exp(-0.3 * li)
        u = rms_norm(x, norm1_g[li])
        proj = jnp.einsum('bld,dc->blc', u, w_in[li])
        q, k, v, hy, gts = jnp.split(proj, splits, axis=-1)
        q = q.reshape(b, l, ATTN_HEADS, 2, QK_DIM).transpose(0, 2, 3, 1, 4)
        k = k.reshape(b, l, ATTN_HEADS, 2, QK_DIM).transpose(0, 2, 3, 1, 4)
        v = v.reshape(b, l, ATTN_HEADS, V_DIM).transpose(0, 2, 1, 3)
        q = rope_partial(rms_norm(q, q_norm_g[li]), cos, sin)
        k = rope_partial(rms_norm(k, k_norm_g[li]), cos, sin)
        lam = (jnp.exp(jnp.sum(lambda_q1[li] * lambda_k1[li]).astype(jnp.float32))
               - jnp.exp(jnp.sum(lambda_q2[li] * lambda_k2[li]).astype(jnp.float32))
               + lambda_init)
        attn = diff_attention(q, k, v, lam, subln_g[li], lambda_init)

        spec = hyena_filter_spectra(l, filt_w1[li], filt_b1[li], filt_w2[li], filt_b2[li],
                                    filt_w3[li], filt_b3[li], filt_w_out[li], filt_freq[li])
        hyena = hyena_mixer(hy, short_conv_w[li], short_conv_b[li], spec, hyena_skip[li])

        gate = jax.nn.sigmoid(gts.astype(jnp.float32)).astype(x.dtype)
        g_attn, g_hyena = jnp.split(gate, 2, axis=-1)
        merged = (g_attn * jnp.einsum('blc,cd->bld', attn, w_branch_attn[li])
                  + g_hyena * jnp.einsum('blc,cd->bld', hyena, w_branch_hyena[li]))
        x = x + jnp.einsum('bld,de->ble', merged, w_out[li])
        x = x + expert_choice_ffn(rms_norm(x, norm2_g[li]), w_router[li], w_gate[li], w_up[li], w_down[li])
    return x
```

```cpp
#include <hip/hip_runtime.h>
#include <hip/hip_cooperative_groups.h>
#include <cstdio>
#include <cstdint>
#include <cmath>

#ifndef FAST_LEVEL
#define FAST_LEVEL 5
#endif
constexpr int Bn = 4, L = 4096, D = 1024, T = Bn * L;
constexpr int NH = 4, QK = 64, VD = 128, AW = 512;
constexpr int HW = 512, HYC = 1536, GC = 2048, INC = 5120;
constexpr int NE = 16, CAP = 512, EH = 1024;
constexpr float EPS = 1e-6f;
constexpr float LAMBDA_INIT = 0.2f;
constexpr float QSCALE = 0.125f * 1.4426950408889634f;

typedef unsigned short bf16;
__device__ __forceinline__ unsigned f2bf(float f) { unsigned u = __builtin_bit_cast(unsigned, f); return (u + 0x7fffu + ((u >> 16) & 1u)) >> 16; }
__device__ __forceinline__ float bf2f(bf16 h) { return __builtin_bit_cast(float, (unsigned)h << 16); }
__device__ __forceinline__ unsigned pk2(float lo, float hi) { return f2bf(lo) | (f2bf(hi) << 16); }
__device__ __forceinline__ float bflo(unsigned w) { return __builtin_bit_cast(float, w << 16); }
__device__ __forceinline__ float bfhi(unsigned w) { return __builtin_bit_cast(float, w & 0xffff0000u); }

constexpr size_t MiB = 1u << 20;
constexpr size_t WS_CTL = 0;
constexpr size_t WS_RSTD1 = 1 * MiB;
constexpr size_t WS_ROPE = 1 * MiB + 256 * 1024;
constexpr size_t WS_SELTOK = 1 * MiB + 512 * 1024;
constexpr size_t WS_SELGATE = 1 * MiB + 768 * 1024;
constexpr size_t WS_HID3 = 2 * MiB;
constexpr size_t WS_AFF = 3 * MiB;
constexpr size_t WS_WINT = 4 * MiB;
constexpr size_t WS_WPA = 15 * MiB, WS_WPH = 16 * MiB, WS_WO = 17 * MiB;
constexpr size_t WS_XB = 19 * MiB;
constexpr size_t WS_QN = 51 * MiB, WS_KN = 67 * MiB, WS_V = 83 * MiB;
constexpr size_t WS_HYT = 99 * MiB;
constexpr size_t WS_GATES = 147 * MiB;
constexpr size_t WS_ATTN = 211 * MiB, WS_HYENA = 227 * MiB;
constexpr size_t WS_TMPM = 19 * MiB, WS_MERGED = 51 * MiB;
constexpr size_t WS_U2 = 83 * MiB;
constexpr size_t WS_WGU = 115 * MiB, WS_WD = 179 * MiB;
constexpr size_t WS_XIN = 211 * MiB;
constexpr size_t WS_HBUF = 19 * MiB;
constexpr size_t WS_END = 275 * MiB;
constexpr size_t WS_KERNT = 19 * MiB;
constexpr size_t WS_Z0 = 243 * MiB;
constexpr size_t WS_Z1 = 51 * MiB;

struct P {
    const float *x, *norm1_g, *w_in, *scw, *scb, *qng, *kng, *lq1, *lk1, *lq2, *lk2, *subln, *fw1, *fb1, *fw2, *fb2, *fw3, *fb3, *fwo, *ffreq, *hskip, *wpa, *wph, *wo, *norm2_g, *wr, *wg, *wu, *wd;
    float* out; unsigned char* ws;
    int ph_lo, ph_hi;
};

__device__ __forceinline__ float wave_sum(float v) {
#pragma unroll
    for (int o = 1; o < 64; o <<= 1) v += __shfl_xor(v, o);
    return v;
}
__device__ __forceinline__ float static_max_log2(const P& p) {
    float mq = 0.f, mk = 0.f;
    for (int d = 0; d < 64; ++d) { mq = fmaxf(mq, fabsf(p.qng[d])); mk = fmaxf(mk, fabsf(p.kng[d])); }
    return 8.0f * mq * mk * 1.4426950408889634f * 1.01f + 0.05f;
}
__device__ __forceinline__ float calc_lam(const P& p) {
    float a = 0.f, c = 0.f;
    for (int d = 0; d < 64; ++d) { a += p.lq1[d] * p.lk1[d]; c += p.lq2[d] * p.lk2[d]; }
    return expf(a) - expf(c) + LAMBDA_INIT;
}
namespace pg8 {
#define PG8_LAS __attribute__((address_space(3)))
typedef unsigned short bf16_t;
typedef short bf16x8 __attribute__((ext_vector_type(8)));
typedef float f32x4 __attribute__((ext_vector_type(4)));
typedef unsigned u32x4 __attribute__((ext_vector_type(4)));
constexpr int BM = 256, BK = 64, HALF = 128, HTB = HALF * BK * 2  , STAGE_BYTES = 8 * HTB, NXCD = 8, WGM = 8;

__host__ __device__ __forceinline__ int lds_byte(int r, int c) { const int st = (r >> 4) * 2 + (c >> 5), rr = r & 15, cc = c & 31, ob = rr * 64 + cc * 2; return st * 1024 + (ob ^ (((ob >> 9) & 1) << 5)); }
__host__ __device__ __forceinline__ void stage_rc(int b, int& R, int& C) { const int st = b / 1024, sb = b % 1024, swz = sb ^ (((sb >> 9) & 1) << 5); R = (st >> 1) * 16 + swz / 64; C = (st & 1) * 32 + (swz % 64) / 2; }
__host__ __device__ __forceinline__ int perm32(int rho) { const int n = rho >> 4, i = rho & 15; return 8 * (i >> 2) + 4 * n + (i & 3); }

struct Unit { int pm, pn, kind; };
struct Gemm { const bf16_t* A0; const bf16_t* B0; const bf16_t* A1; const bf16_t* B1; int K; };

struct StaticOrder {
    int nM, nN, nwg, G, c;
    __host__ __device__ void init(int M, int N, int G_, int c_) { nM = M / BM; nN = N / BM; nwg = nM * nN; G = G_; c = c_; }
    __host__ __device__ bool next(int i, Unit& u) const {
        const long L = (long)i * G + c; if (L >= nwg) return false;
        int wgid = (int)L; { const int q = nwg / NXCD, r = nwg % NXCD, xcd = wgid % NXCD, off = wgid / NXCD; wgid = (xcd < r ? xcd * (q + 1) : r * (q + 1) + (xcd - r) * q) + off; }
        const int nig = WGM * nN, gid = wgid / nig, fm = gid * WGM, gsz = (nM - fm) < WGM ? (nM - fm) : WGM;
        u.pm = fm + ((wgid % nig) % gsz); u.pn = (wgid % nig) / gsz; u.kind = 0; return true;
    }
    __device__ __forceinline__ void a_ready(const Unit&) const {}
    __device__ __forceinline__ void done(const Unit&) const {}
};

template <class Epi, class Sched, bool ALIGN_EPI = false, bool SP2 = false>
__device__ __forceinline__ void gemm_phase(PG8_LAS unsigned char* lds, const Gemm g, const Sched& S, const Epi& E) {
    const int tid = threadIdx.x, wid = __builtin_amdgcn_readfirstlane(tid >> 6), lane = tid & 63, wr = wid >> 2, wc = wid & 3, fr = lane & 15, fq = lane >> 4;
    const int K = g.K, nt = K / BK;
    unsigned voffA[2], voffB[2];
#pragma unroll
    for (int i = 0; i < 2; ++i) { int R, C; stage_rc(tid * 16 + i * 8192, R, C); const int Rb = Epi::PERM ? ((R & ~31) + perm32(R & 31)) : R;
        voffA[i] = (unsigned)(R * K + C) * 2u; voffB[i] = (unsigned)(Rb * K + C) * 2u; }
    const size_t kstep = (size_t)(BK * 2);
    const size_t hstep = (size_t)HALF * K * 2;
    const size_t tstep = 2 * hstep;
    const unsigned ldsw = (unsigned)wid * 1024u;
    const int aoff = lds_byte(wr * 64 + fr, fq * 8), boff = lds_byte(wc * 32 + fr, fq * 8);
#define PG8_SA(b, h) (((b) * 2 + (h)) * HTB)
#define PG8_SB(b, h) ((4 + (b) * 2 + (h)) * HTB)
#define PG8_STAGE(bufoff, gbase, voff) do { _Pragma("unroll") for (int _i = 0; _i < 2; ++_i) \
        __builtin_amdgcn_global_load_lds((const unsigned*)((const char*)(gbase) + (voff)[_i]), (PG8_LAS unsigned*)(lds + (bufoff) + ldsw + _i * 8192), 16, 0, 0); } while (0)
#define PG8_LDA(dst, b, h) do { _Pragma("unroll") for (int m = 0; m < 4; ++m) _Pragma("unroll") for (int k = 0; k < 2; ++k) dst[m][k] = *(const PG8_LAS bf16x8*)(lds + PG8_SA(b, h) + aoff + m * 2048 + k * 1024); } while (0)
#define PG8_LDB(dst, b, h) do { _Pragma("unroll") for (int n = 0; n < 2; ++n) _Pragma("unroll") for (int k = 0; k < 2; ++k) dst[n][k] = *(const PG8_LAS bf16x8*)(lds + PG8_SB(b, h) + boff + n * 2048 + k * 1024); } while (0)
#define PG8_MMA(ai, bj, At, Bt) do { __builtin_amdgcn_s_setprio(1); _Pragma("unroll") for (int m = 0; m < 4; ++m) _Pragma("unroll") for (int n = 0; n < 2; ++n) _Pragma("unroll") for (int k = 0; k < 2; ++k) \
        acc[ai][bj][m][n] = __builtin_amdgcn_mfma_f32_16x16x32_bf16(Bt[n][k], At[m][k], acc[ai][bj][m][n], 0, 0, 0); __builtin_amdgcn_s_setprio(0); } while (0)
#define PG8_WAIT_V(n) asm volatile("s_waitcnt vmcnt(" #n ")" ::: "memory")
#define PG8_WAIT_L(n) asm volatile("s_waitcnt lgkmcnt(" #n ")" ::: "memory")
#define PG8_BAR __builtin_amdgcn_s_barrier()
#define PG8_SCHED __builtin_amdgcn_sched_barrier(0)
    Unit cur, nxt; int ui = 0;
    if (!S.next(0, cur)) return;
    f32x4 acc[2][2][4][2];
#pragma unroll
    for (int a = 0; a < 2; ++a)
#pragma unroll
        for (int b = 0; b < 2; ++b)
#pragma unroll
            for (int m = 0; m < 4; ++m)
#pragma unroll
                for (int n = 0; n < 2; ++n) acc[a][b][m][n] = (f32x4){0.f, 0.f, 0.f, 0.f};
    bf16x8 At[4][2], B0[2][2], B1[2][2];
    const char* cA = (const char*)(cur.kind ? g.A1 : g.A0) + (size_t)cur.pm * tstep; const char* cB = (const char*)(cur.kind ? g.B1 : g.B0) + (size_t)cur.pn * tstep;
    S.a_ready(cur);
    if constexpr (SP2) {
        PG8_STAGE(PG8_SB(0, 0), cB, voffB); PG8_STAGE(PG8_SB(0, 1), cB + hstep, voffB); PG8_STAGE(PG8_SA(0, 0), cA, voffA); PG8_STAGE(PG8_SA(0, 1), cA + hstep, voffA);
        if (wr == 1) PG8_BAR;
        PG8_WAIT_V(2); PG8_BAR;
        PG8_STAGE(PG8_SB(1, 0), cB + kstep, voffB); PG8_STAGE(PG8_SA(1, 0), cA + kstep, voffA); PG8_STAGE(PG8_SB(1, 1), cB + hstep + kstep, voffB);
        PG8_WAIT_V(6); PG8_BAR;
    } else {
        PG8_STAGE(PG8_SB(0, 0), cB, voffB); PG8_STAGE(PG8_SA(0, 0), cA, voffA); PG8_STAGE(PG8_SB(0, 1), cB + hstep, voffB); PG8_STAGE(PG8_SA(0, 1), cA + hstep, voffA);
        if (wr == 1) PG8_BAR;
        PG8_WAIT_V(4); PG8_BAR;
        PG8_STAGE(PG8_SB(1, 0), cB + kstep, voffB); PG8_STAGE(PG8_SA(1, 0), cA + kstep, voffA); PG8_STAGE(PG8_SB(1, 1), cB + hstep + kstep, voffB);
        PG8_WAIT_V(6); PG8_BAR;
    }
    for (;;) {
        const bool has_next = S.next(ui + 1, nxt);
        const char* nA = has_next ? (const char*)(nxt.kind ? g.A1 : g.A0) + (size_t)nxt.pm * tstep : cA; const char* nB = has_next ? (const char*)(nxt.kind ? g.B1 : g.B0) + (size_t)nxt.pn * tstep : cB;
        for (int t = 0; t < nt; t += 2) {
            const bool last = (t == nt - 2);
            const char* a1 = cA + (size_t)(t + 1) * kstep;
            const char* a2 = last ? nA : cA + (size_t)(t + 2) * kstep; const char* b2 = last ? nB : cB + (size_t)(t + 2) * kstep;
            const char* a3 = a2 + kstep; const char* b3 = b2 + kstep;
            if (last && has_next) S.a_ready(nxt);
            if constexpr (SP2) {
            PG8_LDB(B0, 0, 0); PG8_LDB(B1, 0, 1); PG8_SCHED; PG8_LDA(At, 0, 0); PG8_STAGE(PG8_SA(1, 1), a1 + hstep, voffA);
            PG8_WAIT_V(8); PG8_WAIT_L(0); PG8_BAR; PG8_MMA(0, 0, At, B0); PG8_MMA(0, 1, At, B1); PG8_BAR; PG8_SCHED;
            PG8_LDA(At, 0, 1); PG8_STAGE(PG8_SB(0, 0), b2, voffB); PG8_STAGE(PG8_SB(0, 1), b2 + hstep, voffB); PG8_STAGE(PG8_SA(0, 0), a2, voffA);
            PG8_WAIT_V(8); PG8_WAIT_L(0); PG8_BAR; PG8_MMA(1, 0, At, B0); PG8_MMA(1, 1, At, B1); PG8_BAR; PG8_SCHED;
            PG8_LDB(B0, 1, 0); PG8_LDB(B1, 1, 1); PG8_SCHED; PG8_LDA(At, 1, 0); PG8_STAGE(PG8_SA(0, 1), a2 + hstep, voffA);
            PG8_WAIT_V(8); PG8_WAIT_L(0); PG8_BAR; PG8_MMA(0, 0, At, B0); PG8_MMA(0, 1, At, B1); PG8_BAR; PG8_SCHED;
            PG8_LDA(At, 1, 1); PG8_STAGE(PG8_SB(1, 0), b3, voffB); PG8_STAGE(PG8_SB(1, 1), b3 + hstep, voffB); PG8_STAGE(PG8_SA(1, 0), a3, voffA);
            PG8_WAIT_V(8); PG8_WAIT_L(0); PG8_BAR; PG8_MMA(1, 0, At, B0); PG8_MMA(1, 1, At, B1); PG8_BAR; PG8_SCHED;
            } else {
            PG8_LDB(B0, 0, 0); PG8_SCHED; PG8_LDA(At, 0, 0); PG8_STAGE(PG8_SA(1, 1), a1 + hstep, voffA);
            PG8_WAIT_L(8); PG8_BAR; PG8_WAIT_L(0); PG8_MMA(0, 0, At, B0); PG8_BAR; PG8_SCHED;
            PG8_LDB(B1, 0, 1); PG8_STAGE(PG8_SB(0, 0), b2, voffB);
            PG8_BAR; PG8_WAIT_L(0); PG8_MMA(0, 1, At, B1); PG8_BAR;
            PG8_LDA(At, 0, 1); PG8_STAGE(PG8_SA(0, 0), a2, voffA);
            PG8_BAR; PG8_WAIT_L(0); PG8_MMA(1, 0, At, B0); PG8_BAR; PG8_SCHED;
            PG8_STAGE(PG8_SB(0, 1), b2 + hstep, voffB);
            PG8_WAIT_V(6); PG8_BAR; PG8_MMA(1, 1, At, B1); PG8_BAR;
            PG8_LDB(B0, 1, 0); PG8_SCHED; PG8_LDA(At, 1, 0); PG8_STAGE(PG8_SA(0, 1), a2 + hstep, voffA);
            PG8_WAIT_L(8); PG8_BAR; PG8_WAIT_L(0); PG8_MMA(0, 0, At, B0); PG8_BAR; PG8_SCHED;
            PG8_LDB(B1, 1, 1); PG8_STAGE(PG8_SB(1, 0), b3, voffB);
            PG8_BAR; PG8_WAIT_L(0); PG8_MMA(0, 1, At, B1); PG8_BAR;
            PG8_LDA(At, 1, 1); PG8_STAGE(PG8_SA(1, 0), a3, voffA);
            PG8_BAR; PG8_WAIT_L(0); PG8_MMA(1, 0, At, B0); PG8_BAR; PG8_SCHED;
            PG8_STAGE(PG8_SB(1, 1), b3 + hstep, voffB);
            PG8_WAIT_V(6); PG8_BAR; PG8_MMA(1, 1, At, B1); PG8_BAR;
            }
        }
        if constexpr (ALIGN_EPI) { if (wr == 0) PG8_BAR; }
        if constexpr (!Epi::AFTER_DRAIN) { E(acc, cur, wr, wc, fr, fq); S.done(cur); }
        if (!has_next) break;
#pragma unroll
        for (int a = 0; a < 2; ++a)
#pragma unroll
            for (int b = 0; b < 2; ++b)
#pragma unroll
                for (int m = 0; m < 4; ++m)
#pragma unroll
                    for (int n = 0; n < 2; ++n) acc[a][b][m][n] = (f32x4){0.f, 0.f, 0.f, 0.f};
        cur = nxt; cA = nA; cB = nB; ++ui;
        if constexpr (ALIGN_EPI) { if (wr == 1) PG8_BAR; }
    }
    PG8_WAIT_V(0);
    if constexpr (!ALIGN_EPI) { if (wr == 0) PG8_BAR; }
    PG8_BAR;
    if constexpr (Epi::AFTER_DRAIN) { E.fused(acc, cur, wr, wc, fr, fq, lds, wid, lane); S.done(cur); }
#undef PG8_SA
#undef PG8_SB
#undef PG8_STAGE
#undef PG8_LDA
#undef PG8_LDB
#undef PG8_MMA
#undef PG8_WAIT_V
#undef PG8_WAIT_L
#undef PG8_BAR
#undef PG8_SCHED
}
}
namespace pg8 {
typedef unsigned u32x2 __attribute__((ext_vector_type(2)));
__device__ __forceinline__ unsigned xcd_remap(int L_, int nwg) { const int q = nwg / NXCD, r = nwg % NXCD, xcd = L_ % NXCD, off = L_ / NXCD; return (unsigned)((xcd < r ? xcd * (q + 1) : r * (q + 1) + (xcd - r) * q) + off); }

struct SchedP1 {
    int G, c;
    __device__ bool next(int i, Unit& u) const {
        const int Lx = i * G + c; if (Lx >= 1280) return false;
        if (Lx < 896) { const int wgid = (int)xcd_remap(Lx, 896); const int nig = 8 * 14, gid = wgid / nig, fm = gid * 8; u.pm = fm + ((wgid % nig) % 8); u.pn = (wgid % nig) / 8; u.kind = 0; }
        else { const int wgid = (int)xcd_remap(Lx - 896, 384); u.pm = wgid % 6; u.pn = wgid / 6; u.kind = 1; }
        return true;
    }
    __device__ __forceinline__ void a_ready(const Unit&) const {}
    __device__ __forceinline__ void done(const Unit&) const {}
};
struct EpiInProj {
    static constexpr bool PERM = true, AFTER_DRAIN = false;
    const float* rstd1; const float* rope; const float* gq; const float* gk;
    bf16_t *qn, *kn, *v, *hyT, *gates;
    __device__ __forceinline__ void operator()(const f32x4 (&acc)[2][2][4][2], const Unit& u, int wr, int wc, int fr, int fq) const {
        if (u.kind == 1) {
            const int tok0 = u.pn * BM, b = tok0 / L, l0 = tok0 % L;
            f32x4 rs[2][2];
#pragma unroll
            for (int bj = 0; bj < 2; ++bj)
#pragma unroll
                for (int n = 0; n < 2; ++n) rs[bj][n] = *(const f32x4*)(rstd1 + tok0 + bj * HALF + wc * 32 + 8 * fq + 4 * n);
#pragma unroll
            for (int ai = 0; ai < 2; ++ai)
#pragma unroll
                for (int m = 0; m < 4; ++m) {
                    const int r = u.pm * BM + ai * HALF + wr * 64 + m * 16 + fr;
                    bf16_t* rowp = hyT + ((size_t)b * HYC + r) * L + l0 + wc * 32 + 8 * fq;
#pragma unroll
                    for (int bj = 0; bj < 2; ++bj) { const f32x4 v0 = acc[ai][bj][m][0] * rs[bj][0], v1 = acc[ai][bj][m][1] * rs[bj][1];
                        u32x4 w; w.x = pk2(v0[0], v0[1]); w.y = pk2(v0[2], v0[3]); w.z = pk2(v1[0], v1[1]); w.w = pk2(v1[2], v1[3]);
                        *(u32x4*)(rowp + bj * HALF) = w; }
                }
            return;
        }
        const int row0 = u.pm * BM + wr * 64 + fr;
        if (u.pn < 4) {
            const int gidx = u.pn * 4 + wc, hm = gidx & 7; const bool isq = gidx < 8;
            const float* gain = isq ? gq : gk; bf16_t* dst = isq ? qn : kn;
            float gp[2][8];
#pragma unroll
            for (int bj = 0; bj < 2; ++bj)
#pragma unroll
                for (int t = 0; t < 8; ++t) { const int d = (bj == 0 && fq < 2) ? (4 * fq + (t >> 1) + 8 * (t & 1)) : (32 * bj + 8 * fq + t); gp[bj][t] = gain[d]; }
            const float sc = isq ? QSCALE : 1.0f;
#pragma unroll
            for (int ai = 0; ai < 2; ++ai)
#pragma unroll
                for (int m = 0; m < 4; ++m) {
                    const int tok = row0 + ai * HALF + m * 16, b = tok / L, l = tok % L;
                    const float rr = rstd1[tok];
                    float y[2][8]; float ss = 0.f;
#pragma unroll
                    for (int bj = 0; bj < 2; ++bj)
#pragma unroll
                        for (int t = 0; t < 8; ++t) { y[bj][t] = acc[ai][bj][m][t >> 2][t & 3] * rr; ss += y[bj][t] * y[bj][t]; }
                    ss += __shfl_xor(ss, 16); ss += __shfl_xor(ss, 32);
                    const float rn = 1.0f / sqrtf(ss * (1.0f / 64) + EPS);
#pragma unroll
                    for (int bj = 0; bj < 2; ++bj)
#pragma unroll
                        for (int t = 0; t < 8; ++t) y[bj][t] *= rn * gp[bj][t];
                    if (fq < 2) {
                        const f32x4 cs = *(const f32x4*)(rope + l * 8 + 4 * fq), sn = *(const f32x4*)(rope + L * 8 + l * 8 + 4 * fq);
#pragma unroll
                        for (int j = 0; j < 4; ++j) { const float a = y[0][2 * j], c = y[0][2 * j + 1]; y[0][2 * j] = a * cs[j] - c * sn[j]; y[0][2 * j + 1] = c * cs[j] + a * sn[j]; }
                    }
                    bf16_t* rowp = dst + (((size_t)b * 8 + hm) * L + l) * 64 + 8 * fq;
#pragma unroll
                    for (int bj = 0; bj < 2; ++bj) { u32x4 w; w.x = pk2(y[bj][0] * sc, y[bj][1] * sc); w.y = pk2(y[bj][2] * sc, y[bj][3] * sc); w.z = pk2(y[bj][4] * sc, y[bj][5] * sc); w.w = pk2(y[bj][6] * sc, y[bj][7] * sc);
                        *(u32x4*)(rowp + 32 * bj) = w; }
                }
        } else if (u.pn < 6) {
#pragma unroll
            for (int ai = 0; ai < 2; ++ai)
#pragma unroll
                for (int m = 0; m < 4; ++m) {
                    const int tok = row0 + ai * HALF + m * 16, b = tok / L, l = tok % L; const float rr = rstd1[tok];
#pragma unroll
                    for (int bj = 0; bj < 2; ++bj) { const f32x4 v0 = acc[ai][bj][m][0] * rr, v1 = acc[ai][bj][m][1] * rr;
                        u32x4 w; w.x = pk2(v0[0], v0[1]); w.y = pk2(v0[2], v0[3]); w.z = pk2(v1[0], v1[1]); w.w = pk2(v1[2], v1[3]);
                        *(u32x4*)(v + (((size_t)b * NH + (u.pn - 4) * 2 + bj) * L + l) * VD + 32 * wc + 8 * fq) = w; }
                }
        } else {
#pragma unroll
            for (int ai = 0; ai < 2; ++ai)
#pragma unroll
                for (int m = 0; m < 4; ++m) {
                    const int tok = row0 + ai * HALF + m * 16; const float rr = rstd1[tok];
#pragma unroll
                    for (int bj = 0; bj < 2; ++bj) { float s[8];
#pragma unroll
                        for (int t = 0; t < 8; ++t) s[t] = __builtin_amdgcn_rcpf(1.0f + __builtin_amdgcn_exp2f(-1.4426950408889634f * rr * acc[ai][bj][m][t >> 2][t & 3]));
                        u32x4 w; w.x = pk2(s[0], s[1]); w.y = pk2(s[2], s[3]); w.z = pk2(s[4], s[5]); w.w = pk2(s[6], s[7]);
                        *(u32x4*)(gates + (size_t)tok * GC + (u.pn - 6) * BM + bj * HALF + wc * 32 + 8 * fq) = w; }
                }
        }
    }
};

struct SchedP3 {
    StaticOrder so;
    __device__ bool next(int i, Unit& u) const { if (i >= 2) return false; so.next(0, u); u.kind = i; return true; }
    __device__ __forceinline__ void a_ready(const Unit&) const {}
    __device__ __forceinline__ void done(const Unit&) const {}
};
struct EpiMerge {
    static constexpr bool PERM = true, AFTER_DRAIN = false;
    const bf16_t* gates; bf16_t* tmpm; bf16_t* merged;
    __device__ __forceinline__ void operator()(const f32x4 (&acc)[2][2][4][2], const Unit& u, int wr, int wc, int fr, int fq) const {
        const int row0 = u.pm * BM + wr * 64 + fr, col0 = u.pn * BM + wc * 32 + 8 * fq;
#pragma unroll
        for (int ai = 0; ai < 2; ++ai)
#pragma unroll
            for (int m = 0; m < 4; ++m) {
                const int tok = row0 + ai * HALF + m * 16;
#pragma unroll
                for (int bj = 0; bj < 2; ++bj) {
                    const int col = col0 + bj * HALF;
                    const u32x4 g = *(const u32x4*)(gates + (size_t)tok * GC + u.kind * 1024 + col);
                    float o[8];
#pragma unroll
                    for (int t = 0; t < 4; ++t) { o[2 * t] = bflo(g[t]) * acc[ai][bj][m][t >> 1][(2 * t) & 3]; o[2 * t + 1] = bfhi(g[t]) * acc[ai][bj][m][t >> 1][(2 * t + 1) & 3]; }
                    if (u.kind == 1) { const u32x4 pr = *(const u32x4*)(tmpm + (size_t)tok * D + col);
#pragma unroll
                        for (int t = 0; t < 4; ++t) { o[2 * t] += bflo(pr[t]); o[2 * t + 1] += bfhi(pr[t]); } }
                    u32x4 w; w.x = pk2(o[0], o[1]); w.y = pk2(o[2], o[3]); w.z = pk2(o[4], o[5]); w.w = pk2(o[6], o[7]);
                    *(u32x4*)((u.kind == 1 ? merged : tmpm) + (size_t)tok * D + col) = w;
                }
            }
    }
};

struct EpiOutProj {
    static constexpr bool PERM = false, AFTER_DRAIN = false;
    const float* x; float* out;
    __device__ __forceinline__ void operator()(const f32x4 (&acc)[2][2][4][2], const Unit& u, int wr, int wc, int fr, int fq) const {
        const int row0 = u.pm * BM + wr * 64 + fr, col0 = u.pn * BM + wc * 32 + 4 * fq;
#pragma unroll
        for (int ai = 0; ai < 2; ++ai)
#pragma unroll
            for (int m = 0; m < 4; ++m) { const size_t off = (size_t)(row0 + ai * HALF + m * 16) * D + col0;
#pragma unroll
                for (int bj = 0; bj < 2; ++bj)
#pragma unroll
                    for (int n = 0; n < 2; ++n) { const f32x4 xv = *(const f32x4*)(x + off + bj * HALF + n * 16); *(f32x4*)(out + off + bj * HALF + n * 16) = xv + acc[ai][bj][m][n]; } }
    }
};

struct SchedP7 {
    int G, c;
    __device__ bool next(int i, Unit& u) const {
        const int Lx = i * G + c; if (Lx >= 1024) return false;
        const int wgid = (int)xcd_remap(Lx, 1024), e = wgid >> 6, wl = wgid & 63, pmi = wl & 7, pni = ((wl >> 3) & 3) + 4 * (wl >> 5);
        u.pm = ((pmi >> 1) * 16 + e) * 2 + (pmi & 1); u.pn = e * 8 + pni; u.kind = 0; return true;
    }
    __device__ __forceinline__ void a_ready(const Unit&) const {}
    __device__ __forceinline__ void done(const Unit&) const {}
};
struct EpiGateUp {
    static constexpr bool PERM = true, AFTER_DRAIN = false;
    bf16_t* hbuf;
    __device__ __forceinline__ void operator()(const f32x4 (&acc)[2][2][4][2], const Unit& u, int wr, int wc, int fr, int fq) const {
        const int row0 = u.pm * BM + wr * 64 + fr, col0 = (u.pn & 7) * HALF + wc * 32 + 8 * fq;
#pragma unroll
        for (int ai = 0; ai < 2; ++ai)
#pragma unroll
            for (int m = 0; m < 4; ++m) { float h[8];
#pragma unroll
                for (int t = 0; t < 8; ++t) { const float g = acc[ai][0][m][t >> 2][t & 3], up = acc[ai][1][m][t >> 2][t & 3];
                    h[t] = g * __builtin_amdgcn_rcpf(1.0f + __builtin_amdgcn_exp2f(-1.4426950408889634f * g)) * up; }
                u32x4 w; w.x = pk2(h[0], h[1]); w.y = pk2(h[2], h[3]); w.z = pk2(h[4], h[5]); w.w = pk2(h[6], h[7]);
                *(u32x4*)(hbuf + (size_t)(row0 + ai * HALF + m * 16) * EH + col0) = w; }
    }
};
struct SchedP8 {
    int G, c;
    __device__ bool next(int i, Unit& u) const {
        const int Lx = i * G + c; if (Lx >= 512) return false;
        const int wgid = (int)xcd_remap(Lx, 512), e = wgid >> 5, wl = wgid & 31, pmi = wl & 7, pni = wl >> 3;
        u.pm = ((pmi >> 1) * 16 + e) * 2 + (pmi & 1); u.pn = e * 4 + pni; u.kind = 0; return true;
    }
    __device__ __forceinline__ void a_ready(const Unit&) const {}
    __device__ __forceinline__ void done(const Unit&) const {}
};
struct EpiDown {
    static constexpr bool PERM = false, AFTER_DRAIN = false;
    const int* seltok; const float* selgate; float* out;
    __device__ __forceinline__ void operator()(const f32x4 (&acc)[2][2][4][2], const Unit& u, int wr, int wc, int fr, int fq) const {
        const int g = u.pm >> 1, b = g >> 4, slot0 = (u.pm & 1) * BM + wr * 64 + fr, col0 = (u.pn & 3) * BM + wc * 32 + 4 * fq;
#pragma unroll
        for (int ai = 0; ai < 2; ++ai)
#pragma unroll
            for (int m = 0; m < 4; ++m) { const int slot = g * CAP + slot0 + ai * HALF + m * 16; const int tok = seltok[slot]; const float gt = selgate[slot];
                float* rowp = out + (size_t)(b * L + tok) * D + col0;
#pragma unroll
                for (int bj = 0; bj < 2; ++bj)
#pragma unroll
                    for (int n = 0; n < 2; ++n)
#pragma unroll
                        for (int e = 0; e < 4; ++e) atomicAdd(rowp + bj * HALF + n * 16 + e, gt * acc[ai][bj][m][n][e]); }
    }
};
}
namespace attn {
typedef short bf16x8 __attribute__((ext_vector_type(8)));
typedef short s16x4 __attribute__((ext_vector_type(4)));
typedef float f32x16 __attribute__((ext_vector_type(16)));
typedef unsigned u32x4 __attribute__((ext_vector_type(4)));
typedef float f32x2_t __attribute__((ext_vector_type(2))); typedef __bf16 bf16x2_t __attribute__((ext_vector_type(2)));
typedef __attribute__((address_space(3))) const char* lds_cptr;
typedef short v4i16_t __attribute__((ext_vector_type(4)));
constexpr int SLOT = 32768, NSLOT = 3, OFF_K1 = 0, OFF_K2 = 8192, OFF_V = 16384;
constexpr int OFF_X = 0, OFF_STG = 65536, OFF_WSF = 98304;
__device__ __forceinline__ int crow(int r, int hi) { return (r & 3) + 8 * (r >> 2) + 4 * hi; }
__device__ __forceinline__ void glds16(const void* gsrc, unsigned lds_dst) { unsigned keep;
    asm volatile("s_mov_b32 %0, m0\n\ts_mov_b32 m0, %2\n\ts_nop 0\n\tglobal_load_lds_dwordx4 %1, off\n\ts_mov_b32 m0, %0" : "=&s"(keep) : "v"(gsrc), "s"(lds_dst) : "memory"); }
__device__ __forceinline__ unsigned cvtpk(float lo, float hi) { f32x2_t v = {lo, hi}; bf16x2_t b = __builtin_convertvector(v, bf16x2_t); return __builtin_bit_cast(unsigned, b); }
__device__ __forceinline__ s16x4 vtr(lds_cptr p) { return __builtin_bit_cast(s16x4, __builtin_amdgcn_ds_read_tr16_b64_v4i16((__attribute__((address_space(3))) v4i16_t*)p)); }
#define ATT_WAIT_BAR(N) asm volatile("s_waitcnt vmcnt(" #N ") lgkmcnt(0)\n\ts_barrier" ::: "memory")

__device__ __forceinline__ void attn_unit(int b, int h, int qb, const bf16* qn, const bf16* kn, const bf16* vv, bf16* attn_out, const float* subln, float M2, float lam,
                                          __attribute__((address_space(3))) unsigned char* lds) {
    const int tid = threadIdx.x, lane = tid & 63, r32 = lane & 31, hi = lane >> 5; const int wid = __builtin_amdgcn_readfirstlane(tid >> 6);
    const int map = wid >> 2, qg = wid & 3;
    const unsigned lds0 = (unsigned)(uintptr_t)lds;
    const bf16* k1src = kn + (((size_t)b * 8 + h * 2 + 0) * L) * 64 + (size_t)lane * 64 + wid * 8;
    const bf16* k2src = kn + (((size_t)b * 8 + h * 2 + 1) * L) * 64 + (size_t)lane * 64 + wid * 8;
    const bf16* vbase = vv + (((size_t)b * NH + h) * L) * VD;
    const int pi0 = wid, pi1 = wid + 8;
    const bf16* v0src = vbase + (size_t)(16 * (pi0 & 3) + (lane >> 2)) * VD + (pi0 >> 2) * 32 + (lane & 3) * 8;
    const bf16* v1src = vbase + (size_t)(16 * (pi1 & 3) + (lane >> 2)) * VD + (pi1 >> 2) * 32 + (lane & 3) * 8;
#define ATT_DMA(t, slot) do { \
        glds16(k1src + (size_t)(t) * 64 * 64, (unsigned)__builtin_amdgcn_readfirstlane(lds0 + (slot) + OFF_K1 + wid * 1024)); \
        glds16(k2src + (size_t)(t) * 64 * 64, (unsigned)__builtin_amdgcn_readfirstlane(lds0 + (slot) + OFF_K2 + wid * 1024)); \
        glds16(v0src + (size_t)(t) * 64 * VD, (unsigned)__builtin_amdgcn_readfirstlane(lds0 + (slot) + OFF_V + pi0 * 1024)); \
        glds16(v1src + (size_t)(t) * 64 * VD, (unsigned)__builtin_amdgcn_readfirstlane(lds0 + (slot) + OFF_V + pi1 * 1024)); } while (0)
    constexpr int NT = L / 64;
    ATT_DMA(0, 0); ATT_DMA(1, SLOT);
    const int q0 = qb * 128 + qg * 32;
    const bf16* Qw = qn + (((size_t)b * 8 + h * 2 + map) * L + q0) * 64;
    bf16x8 qr[4];
#pragma unroll
    for (int d0 = 0; d0 < 4; ++d0) qr[d0] = *reinterpret_cast<const bf16x8*>(Qw + (size_t)r32 * 64 + d0 * 16 + hi * 8);
    f32x16 negm;
#pragma unroll
    for (int r = 0; r < 16; ++r) negm[r] = -M2;
    f32x16 o[4];
#pragma unroll
    for (int d = 0; d < 4; ++d) o[d] = f32x16{};
    float lsum = 0.f;
    const lds_cptr lds3 = (lds_cptr)lds;
    const lds_cptr kp0 = lds3 + (map ? OFF_K2 : OFF_K1) + hi * 1024 + r32 * 16;
    const lds_cptr vp0 = lds3 + OFF_V + ((lane >> 4) & 1) * 32 + (lane & 3) * 8 + (4 * hi + ((lane & 15) >> 2)) * 64;
    int sl_cur = 0, sl_nn = 2 * SLOT;
    for (int t = 0; t < NT; ++t) {
        if (t + 1 < NT) { ATT_WAIT_BAR(4); } else { ATT_WAIT_BAR(0); }
        if (t + 2 < NT) ATT_DMA(t + 2, sl_nn);
        const lds_cptr kp = kp0 + sl_cur, vp = vp0 + sl_cur;
        f32x16 p0, p1;
#pragma unroll
        for (int d0 = 0; d0 < 4; ++d0) {
            const bf16x8 b0 = *(const __attribute__((address_space(3))) bf16x8*)(kp + d0 * 2048);
            const bf16x8 b1 = *(const __attribute__((address_space(3))) bf16x8*)(kp + d0 * 2048 + 512);
            if (d0 == 0) { p0 = __builtin_amdgcn_mfma_f32_32x32x16_bf16(b0, qr[0], negm, 0, 0, 0); p1 = __builtin_amdgcn_mfma_f32_32x32x16_bf16(b1, qr[0], negm, 0, 0, 0); }
            else { p0 = __builtin_amdgcn_mfma_f32_32x32x16_bf16(b0, qr[d0], p0, 0, 0, 0); p1 = __builtin_amdgcn_mfma_f32_32x32x16_bf16(b1, qr[d0], p1, 0, 0, 0); }
        }
        float sa = 0.f, sb = 0.f;
#pragma unroll
        for (int r = 0; r < 16; ++r) { p0[r] = __builtin_amdgcn_exp2f(p0[r]); p1[r] = __builtin_amdgcn_exp2f(p1[r]); sa += p0[r]; sb += p1[r]; }
        lsum += sa + sb;
        u32x4 pw[4];
#pragma unroll
        for (int i = 0; i < 4; ++i) { pw[0][i] = cvtpk(p0[2 * i], p0[2 * i + 1]); pw[1][i] = cvtpk(p0[8 + 2 * i], p0[9 + 2 * i]); pw[2][i] = cvtpk(p1[2 * i], p1[2 * i + 1]); pw[3][i] = cvtpk(p1[8 + 2 * i], p1[9 + 2 * i]); }
#pragma unroll
        for (int db = 0; db < 4; ++db) {
#pragma unroll
            for (int ks = 0; ks < 4; ++ks) {
                const s16x4 lo = vtr(vp + db * 4096 + ks * 1024), hh = vtr(vp + db * 4096 + ks * 1024 + 512);
                const bf16x8 vf = (bf16x8){lo[0], lo[1], lo[2], lo[3], hh[0], hh[1], hh[2], hh[3]};
                o[db] = __builtin_amdgcn_mfma_f32_32x32x16_bf16(__builtin_bit_cast(bf16x8, pw[ks]), vf, o[db], 0, 0, 0);
            }
        }
        sl_cur = (sl_cur == (NSLOT - 1) * SLOT) ? 0 : sl_cur + SLOT;
        sl_nn = (sl_nn == (NSLOT - 1) * SLOT) ? 0 : sl_nn + SLOT;
    }
    { auto rr = __builtin_amdgcn_permlane32_swap(__float_as_uint(lsum), __float_as_uint(lsum), false, false); lsum = __uint_as_float(rr[0]) + __uint_as_float(rr[1]); }
    __attribute__((address_space(3))) float* wsf = (__attribute__((address_space(3))) float*)(lds + OFF_WSF) + wid * 64;
    asm volatile("s_waitcnt lgkmcnt(0)\n\ts_barrier" ::: "memory");
    if (hi == 0) wsf[r32] = lsum;
    asm volatile("s_waitcnt lgkmcnt(0)" ::: "memory");
    float rli[16];
#pragma unroll
    for (int r = 0; r < 16; ++r) rli[r] = __builtin_amdgcn_rcpf(wsf[crow(r, hi)]) * (map ? lam : 1.0f);
    __attribute__((address_space(3))) float* X = (__attribute__((address_space(3))) float*)(lds + OFF_X) + qg * 4096;
    if (map == 1) {
#pragma unroll
        for (int db = 0; db < 4; ++db)
#pragma unroll
            for (int r = 0; r < 16; ++r) X[crow(r, hi) * 128 + db * 32 + r32] = o[db][r] * rli[r];
    }
    asm volatile("s_waitcnt lgkmcnt(0)\n\ts_barrier" ::: "memory");
    if (map == 0) {
        float ss[16];
#pragma unroll
        for (int r = 0; r < 16; ++r) ss[r] = 0.f;
#pragma unroll
        for (int db = 0; db < 4; ++db)
#pragma unroll
            for (int r = 0; r < 16; ++r) { const float val = o[db][r] * rli[r] - X[crow(r, hi) * 128 + db * 32 + r32]; o[db][r] = val; ss[r] += val * val; }
#pragma unroll
        for (int r = 0; r < 16; ++r) { float s = ss[r]; s += __shfl_xor(s, 1); s += __shfl_xor(s, 2); s += __shfl_xor(s, 4); s += __shfl_xor(s, 8); s += __shfl_xor(s, 16);
            ss[r] = (1.0f - LAMBDA_INIT) / sqrtf(s * (1.0f / 128) + EPS); }
        __attribute__((address_space(3))) bf16* stg = (__attribute__((address_space(3))) bf16*)(lds + OFF_STG) + qg * 4096;
#pragma unroll
        for (int db = 0; db < 4; ++db) { const float gg = subln[db * 32 + r32];
#pragma unroll
            for (int r = 0; r < 16; ++r) stg[crow(r, hi) * 128 + db * 32 + r32] = (bf16)f2bf(o[db][r] * ss[r] * gg); }
        asm volatile("s_waitcnt lgkmcnt(0)" ::: "memory");
        bf16* Ow = attn_out + ((size_t)b * L + q0) * AW + h * VD;
#pragma unroll
        for (int i = 0; i < 8; ++i) { const int row = i * 4 + (lane >> 4), ch = lane & 15;
            const u32x4 val = *(const __attribute__((address_space(3))) u32x4*)(stg + row * 128 + ch * 8);
            *(u32x4*)(Ow + (size_t)row * AW + ch * 8) = val; }
    }
    asm volatile("s_waitcnt lgkmcnt(0)\n\ts_barrier" ::: "memory");
#undef ATT_DMA
}
#undef ATT_WAIT_BAR
}
namespace hy {
typedef float f32x2 __attribute__((ext_vector_type(2)));
typedef float f32x4v __attribute__((ext_vector_type(4)));
#define HLAS __attribute__((address_space(3)))
constexpr int N = 8192, OFF_BUF = 0, OFF_H1 = 69632, OFF_H2 = 69632 + 32832, HY_LDS_END = 69632 + 2 * 32832;
__device__ __forceinline__ int phys(int i) { return i + (i >> 4); }
__device__ __forceinline__ int opq(int x) { asm volatile("" : "+v"(x)); return x; }
__device__ __forceinline__ f32x2 cmul(f32x2 a, f32x2 b) { return (f32x2){a.x * b.x - a.y * b.y, a.x * b.y + a.y * b.x}; }
__device__ __forceinline__ f32x2 cmulc(f32x2 a, f32x2 b) { return (f32x2){a.x * b.x + a.y * b.y, a.y * b.x - a.x * b.y}; }
__device__ __forceinline__ f32x2 twid(float frac) { return (f32x2){__builtin_amdgcn_cosf(frac), __builtin_amdgcn_sinf(frac)}; }
__device__ __forceinline__ f32x2 mul_mi(f32x2 a) { return (f32x2){a.y, -a.x}; }
#define HY_FFT4(a0, a1, a2, a3, r0, r1, r2, r3) do { const f32x2 t0_ = a0 + a2, t1_ = a0 - a2, t2_ = a1 + a3, t3_ = mul_mi(a1 - a3); r0 = t0_ + t2_; r1 = t1_ + t3_; r2 = t0_ - t2_; r3 = t1_ - t3_; } while (0)
__device__ __forceinline__ void fft16(const f32x2 (&u)[16], f32x2 (&v)[16]) {
    constexpr float C1 = 0.92387953251128674f, S1 = 0.38268343236508977f, R2 = 0.70710678118654752f;
    f32x2 y[16];
#pragma unroll
    for (int n1 = 0; n1 < 4; ++n1) HY_FFT4(u[n1], u[n1 + 4], u[n1 + 8], u[n1 + 12], y[n1], y[n1 + 4], y[n1 + 8], y[n1 + 12]);
    y[5] = cmul(y[5], (f32x2){C1, -S1});  y[9] = cmul(y[9], (f32x2){R2, -R2});   y[13] = cmul(y[13], (f32x2){S1, -C1});
    y[6] = cmul(y[6], (f32x2){R2, -R2});  y[10] = mul_mi(y[10]);                 y[14] = cmul(y[14], (f32x2){-R2, -R2});
    y[7] = cmul(y[7], (f32x2){S1, -C1});  y[11] = cmul(y[11], (f32x2){-R2, -R2}); y[15] = cmul(y[15], (f32x2){-C1, S1});
#pragma unroll
    for (int k2 = 0; k2 < 4; ++k2) HY_FFT4(y[4 * k2], y[4 * k2 + 1], y[4 * k2 + 2], y[4 * k2 + 3], v[k2], v[4 + k2], v[8 + k2], v[12 + k2]);
}
__device__ __forceinline__ void load16(const HLAS f32x2* buf, int tid, f32x2 (&u)[16]) {
    const HLAS f32x2* b = buf + phys(tid);
#pragma unroll
    for (int r = 0; r < 16; ++r) u[r] = b[544 * r];
}
template <int PS> __device__ __forceinline__ void store16(HLAS f32x2* buf, int j, const f32x2 (&v)[16]) {
    HLAS f32x2* b = buf + phys(j);
#pragma unroll
    for (int r = 0; r < 16; ++r) b[PS * r] = v[r];
}
__device__ __forceinline__ void twiddle16(f32x2 (&u)[16], int k, float inv_pr) {
    const f32x2 w1 = twid(-(float)k * inv_pr); f32x2 w = w1;
#pragma unroll
    for (int r = 1; r < 16; ++r) { u[r] = cmul(u[r], w); w = cmul(w, w1); }
}
__device__ __forceinline__ void passes_bc(HLAS f32x2* buf, int tid_) {
    f32x2 u[16], v[16];
    int tid = opq(tid_);
    load16(buf, tid, u); __syncthreads();
    { const int k = tid & 15; twiddle16(u, k, 1.0f / 256.0f); fft16(u, v); store16<17>(buf, (tid - k) * 16 + k, v); }
    __syncthreads();
    tid = opq(tid_);
    load16(buf, tid, u); __syncthreads();
    { const int k = tid & 255; twiddle16(u, k, 1.0f / 4096.0f); fft16(u, v); store16<272>(buf, (tid - k) * 16 + k, v); }
    __syncthreads();
}
__device__ __forceinline__ void fft_lds(HLAS f32x2* buf, int tid_) {
    int tid = opq(tid_);
    { f32x2 u[16], v[16]; load16(buf, tid, u); __syncthreads(); fft16(u, v); store16<1>(buf, tid * 16, v); }
    __syncthreads();
    passes_bc(buf, tid_);
    tid = opq(tid_);
    { HLAS f32x2* b = buf + phys(tid);
#pragma unroll
    for (int q = 0; q < 8; ++q) { const int ii = tid + 512 * q; const f32x2 a = b[544 * q], c = cmul(b[544 * (q + 8)], twid(-(float)ii * (1.0f / 8192.0f)));
        b[544 * q] = a + c; b[544 * (q + 8)] = a - c; } }
    __syncthreads();
}
__device__ __forceinline__ void conv_apply(HLAS f32x2* buf, const HLAS f32x2* Hh, int tid, const float (&zr)[8], const float (&zi)[8], float (&yr)[8], float (&yi)[8]) {
    const int tid_ = tid;
    __syncthreads();
    tid = opq(tid_);
    { f32x2 u[16], v[16];
#pragma unroll
      for (int r = 0; r < 8; ++r) { u[r] = (f32x2){zr[r], zi[r]}; u[r + 8] = (f32x2){0.f, 0.f}; }
      fft16(u, v); store16<1>(buf, tid * 16, v); }
    __syncthreads();
    passes_bc(buf, tid_);
    tid = opq(tid_);
    { HLAS f32x2* b = buf + phys(tid); const HLAS f32x2* ha = Hh + tid; const HLAS f32x2* hb = Hh + (4096 - 512 * 7) - tid;
#pragma unroll
    for (int q = 0; q < 8; ++q) { const int ii = tid + 512 * q; const f32x2 a = b[544 * q], c = cmul(b[544 * (q + 8)], twid(-(float)ii * (1.0f / 8192.0f)));
        const f32x2 d0 = a + c, d1 = a - c, h0 = ha[512 * q], h1 = hb[512 * (7 - q)];
        const f32x2 y0 = cmul(d0, h0), y1 = cmulc(d1, h1);
        b[544 * q] = (f32x2){y0.x, -y0.y}; b[544 * (q + 8)] = (f32x2){y1.x, -y1.y}; } }
    __syncthreads();
    tid = opq(tid_);
    { f32x2 u[16], v[16]; load16(buf, tid, u); __syncthreads(); fft16(u, v); store16<1>(buf, tid * 16, v); }
    __syncthreads();
    passes_bc(buf, tid_);
    tid = opq(tid_);
    { const HLAS f32x2* b = buf + phys(tid);
#pragma unroll
    for (int q = 0; q < 8; ++q) { const int ii = tid + 512 * q; const f32x2 a = b[544 * q], c = cmul(b[544 * (q + 8)], twid(-(float)ii * (1.0f / 8192.0f)));
        const f32x2 r = a + c; yr[q] = r.x; yi[q] = -r.y; } }
}
__device__ __forceinline__ float sconv(const bf16* h, int l, float w0, float w1, float w2, float bias) {
    float v = bf2f(h[l]) * w1 + bias;
    if (l > 0) v += bf2f(h[l - 1]) * w0;
    if (l < L - 1) v += bf2f(h[l + 1]) * w2;
    return v;
}
__device__ __forceinline__ void hyena_channel(const P& p, int c, HLAS unsigned char* lds, int tid_) {
    int tid = opq(tid_);
    HLAS f32x2* buf = (HLAS f32x2*)(lds + OFF_BUF); HLAS f32x2* H1 = (HLAS f32x2*)(lds + OFF_H1); HLAS f32x2* H2 = (HLAS f32x2*)(lds + OFF_H2);
    const float* hid3 = (const float*)(p.ws + WS_HID3);
    const bf16* hyT = (const bf16*)(p.ws + WS_HYT); bf16* hyo = (bf16*)(p.ws + WS_HYENA);
    __syncthreads();
    {
        float f[8][4];
#pragma unroll
        for (int q = 0; q < 8; ++q)
#pragma unroll
            for (int od = 0; od < 4; ++od) f[q][od] = 0.f;
#pragma unroll 1
        for (int jc = 0; jc < 16; ++jc) {
            float wv[4][4];
#pragma unroll
            for (int jj = 0; jj < 4; ++jj)
#pragma unroll
                for (int od = 0; od < 4; ++od) wv[jj][od] = p.fwo[(size_t)(4 * jc + jj) * 2048 + od * 512 + c];
#pragma unroll
            for (int q = 0; q < 8; ++q) { const f32x4v h = *(const f32x4v*)(hid3 + (size_t)(tid + 512 * q) * 64 + 4 * jc);
#pragma unroll
                for (int od = 0; od < 4; ++od) f[q][od] += h[0] * wv[0][od] + h[1] * wv[1][od] + h[2] * wv[2][od] + h[3] * wv[3][od]; }
        }
        const float mind = logf(1e-2f) / 1.5f, maxd = logf(1e-2f) / 0.3f;
        const float delta = fabsf(mind + (maxd - mind) * (float)c / 511.0f);
#pragma unroll
        for (int q = 0; q < 8; ++q) { const int l = tid + 512 * q; const float dec = expf(-((float)l / (float)(L - 1)) * delta);
            buf[phys(l)] = (f32x2){f[q][0] * dec, f[q][2] * dec};
            if (l >= 1) buf[phys(N - l)] = (f32x2){f[q][1] * dec, f[q][3] * dec}; }
        if (tid == 0) buf[phys(4096)] = (f32x2){0.f, 0.f};
    }
    __syncthreads();
    fft_lds(buf, tid_);
    tid = opq(tid_);
#pragma unroll
    for (int q = 0; q < 8; ++q) { const int k = tid + 512 * q; const f32x2 wk = buf[phys(k)], wn = buf[phys((N - k) & (N - 1))];
        const float s = 0.5f / (float)N;
        H1[k] = (f32x2){(wk.x + wn.x) * s, (wk.y - wn.y) * s};
        H2[k] = (f32x2){(wk.y + wn.y) * s, (wn.x - wk.x) * s}; }
    if (tid == 0) { const f32x2 wk = buf[phys(4096)]; H1[4096] = (f32x2){wk.x / (float)N, 0.f}; H2[4096] = (f32x2){wk.y / (float)N, 0.f}; }
    const float w0z = p.scw[c], w1z = p.scw[HYC + c], w2z = p.scw[2 * HYC + c], bz = p.scb[c];
    const float w0a = p.scw[512 + c], w1a = p.scw[HYC + 512 + c], w2a = p.scw[2 * HYC + 512 + c], ba = p.scb[512 + c];
    const float w0b = p.scw[1024 + c], w1b = p.scw[HYC + 1024 + c], w2b = p.scw[2 * HYC + 1024 + c], bb = p.scb[1024 + c];
    const float sk1 = p.hskip[c], sk2 = p.hskip[512 + c];
#pragma unroll 1
    for (int pp = 0; pp < 2; ++pp) {
        const int b0 = 2 * pp, b1 = 2 * pp + 1;
        const bf16* z0p = hyT + ((size_t)b0 * HYC + c) * L; const bf16* z1p = hyT + ((size_t)b1 * HYC + c) * L;
        float zr[8], zi[8], yr[8], yi[8];
        tid = opq(tid_);
#pragma unroll
        for (int q = 0; q < 8; ++q) { const int l = tid + 512 * q; zr[q] = sconv(z0p, l, w0z, w1z, w2z, bz); zi[q] = sconv(z1p, l, w0z, w1z, w2z, bz); }
        conv_apply(buf, H1, tid_, zr, zi, yr, yi);
        tid = opq(tid_);
#pragma unroll
        for (int q = 0; q < 8; ++q) { const int l = tid + 512 * q;
            zr[q] = sconv(z0p + (size_t)512 * L, l, w0a, w1a, w2a, ba) * (yr[q] + sk1 * zr[q]);
            zi[q] = sconv(z1p + (size_t)512 * L, l, w0a, w1a, w2a, ba) * (yi[q] + sk1 * zi[q]); }
        conv_apply(buf, H2, tid_, zr, zi, yr, yi);
        tid = opq(tid_);
#pragma unroll
        for (int q = 0; q < 8; ++q) { const int l = tid + 512 * q;
            const float o0 = sconv(z0p + (size_t)1024 * L, l, w0b, w1b, w2b, bb) * (yr[q] + sk2 * zr[q]);
            const float o1 = sconv(z1p + (size_t)1024 * L, l, w0b, w1b, w2b, bb) * (yi[q] + sk2 * zi[q]);
            hyo[((size_t)b0 * L + l) * HW + c] = (bf16)f2bf(o0); hyo[((size_t)b1 * L + l) * HW + c] = (bf16)f2bf(o1); }
    }
    __syncthreads();
}
#undef HLAS
}
#define LAS __attribute__((address_space(3)))
constexpr int NWAVES = 8, NTHR = 512;
constexpr int RING_BYTES = 131072, LDS_BYTES = 147456;
#define LDS_WAIT() asm volatile("s_waitcnt lgkmcnt(0)" ::: "memory")

__device__ __forceinline__ int colmap_in(int R) {
    if (R >= 3584) return 1536 + (R - 3584);
    const int pn = R >> 8, rt = R & 255;
    if (pn < 4) { const int bj = rt >> 7, wc = (rt >> 5) & 3, i = rt & 31, gidx = pn * 4 + wc;
        const int d = (bj == 0 && i < 16) ? (4 * (i >> 3) + ((i & 7) >> 1) + 8 * (i & 1)) : (32 * bj + i);
        return gidx * 64 + d; }
    if (pn < 6) return 1024 + (pn - 4) * 256 + rt;
    return 3072 + (pn - 6) * 256 + rt;
}
__device__ __forceinline__ void transpose_item(const float* W, int N, int K, bf16* WT, int k0, int drow0, int scol, const float* kscale, LAS float* scr, int lane) {
#pragma unroll 8
    for (int i = 0; i < 32; ++i) { const int kk = 2 * i + (lane >> 5); float v = W[(size_t)(k0 + kk) * N + scol]; if (kscale) v *= kscale[k0 + kk]; scr[kk * 33 + (lane & 31)] = v; }
    LDS_WAIT(); asm volatile("" ::: "memory");
    const int c = lane & 7;
#pragma unroll
    for (int j = 0; j < 4; ++j) { const int n = (lane >> 3) + 8 * j; const LAS float* s = scr + (8 * c) * 33 + n;
        uint4 o; o.x = pk2(s[0 * 33], s[1 * 33]); o.y = pk2(s[2 * 33], s[3 * 33]); o.z = pk2(s[4 * 33], s[5 * 33]); o.w = pk2(s[6 * 33], s[7 * 33]);
        *(uint4*)(WT + (size_t)(drow0 + n) * K + k0 + 8 * c) = o; }
    LDS_WAIT(); asm volatile("" ::: "memory");
}
__device__ __forceinline__ void p0_prologue(const P& p, LAS unsigned char* lds, int gw, int NGW, int wave, int lane, int gt, int NGT) {
    LAS float* scr = (LAS float*)(lds + wave * 16384);
    unsigned char* ws = p.ws;
    constexpr int I_IN = 16 * 160, I_PA = 8 * 32, I_O = 16 * 32, NITEMS = I_IN + 2 * I_PA + I_O;
    for (int it = gw; it < NITEMS; it += NGW) {
        int r = it;
        if (r < I_IN) { const int kb = r / 160, nb = r % 160; transpose_item(p.w_in, INC, D, (bf16*)(ws + WS_WINT), kb * 64, nb * 32, colmap_in(nb * 32 + (lane & 31)), p.norm1_g, scr, lane); continue; } r -= I_IN;
        if (r < I_PA) { const int kb = r / 32, nb = r % 32; transpose_item(p.wpa, D, 512, (bf16*)(ws + WS_WPA), kb * 64, nb * 32, nb * 32 + (lane & 31), nullptr, scr, lane); continue; } r -= I_PA;
        if (r < I_PA) { const int kb = r / 32, nb = r % 32; transpose_item(p.wph, D, 512, (bf16*)(ws + WS_WPH), kb * 64, nb * 32, nb * 32 + (lane & 31), nullptr, scr, lane); continue; } r -= I_PA;
        { const int kb = r / 32, nb = r % 32; transpose_item(p.wo, D, D, (bf16*)(ws + WS_WO), kb * 64, nb * 32, nb * 32 + (lane & 31), nullptr, scr, lane); }
    }
    float* rstd1 = (float*)(ws + WS_RSTD1); bf16* xb = (bf16*)(ws + WS_XB);
    for (int t = gw; t < T; t += NGW) {
        const float4* xr = (const float4*)(p.x + (size_t)t * D);
        float s = 0.f;
#pragma unroll
        for (int j = 0; j < 4; ++j) { const float4 v = xr[lane + 64 * j]; s += v.x * v.x + v.y * v.y + v.z * v.z + v.w * v.w;
            uint2 pk; pk.x = pk2(v.x, v.y); pk.y = pk2(v.z, v.w); ((uint2*)(xb + (size_t)t * D))[lane + 64 * j] = pk; }
        s = wave_sum(s);
        if (lane == 0) rstd1[t] = 1.0f / sqrtf(s * (1.0f / D) + EPS);
    }
    float* rc = (float*)(ws + WS_ROPE); float* rs = rc + L * 8;
    for (int i = gt; i < L * 8; i += NGT) {
        const int l = i >> 3, j = i & 7;
        const double ang = (double)l * pow(500000.0, -(double)j / 8.0);
        rc[i] = (float)cos(ang); rs[i] = (float)sin(ang);
    }
    float* hid3 = (float*)(ws + WS_HID3);
    for (int l = gw; l < L; l += NGW) {
        const float t = (float)l / (float)(L - 1);
        const float fr = p.ffreq[lane];
        float a = p.fb1[lane] + t * p.fw1[lane];
        for (int j = 0; j < 16; ++j) {
            const float band = 1e-4f + (float)j * ((15.0f - 1e-4f) / 15.0f);
            const float ang = (2.0f * 3.14159265358979323846f / (float)L) * (float)l * band;
            a += cosf(ang) * p.fw1[(1 + j) * 64 + lane] - sinf(ang) * p.fw1[(17 + j) * 64 + lane];
        }
        float h = sinf(fr * a);
        float a2 = p.fb2[lane];
        for (int i = 0; i < 64; ++i) a2 += __shfl(h, i) * p.fw2[i * 64 + lane];
        h = sinf(fr * a2);
        float a3 = p.fb3[lane];
        for (int i = 0; i < 64; ++i) a3 += __shfl(h, i) * p.fw3[i * 64 + lane];
        hid3[l * 64 + lane] = sinf(fr * a3);
    }
}

__device__ __forceinline__ void p5_router(const P& p, LAS unsigned char* lds, int gw, int NGW, int tid, int lane) {
    LAS float* wrT = (LAS float*)lds;
    for (int i = tid; i < D * NE; i += NTHR) { const int d = i >> 4, e = i & 15; wrT[e * D + d] = p.wr[i]; }
    __syncthreads();
    float* aff = (float*)(p.ws + WS_AFF); bf16* u2 = (bf16*)(p.ws + WS_U2);
    for (int t = gw; t < T; t += NGW) {
        const float4* xr = (const float4*)(p.out + (size_t)t * D);
        float4 u[4]; float s = 0.f;
#pragma unroll
        for (int j = 0; j < 4; ++j) { u[j] = xr[lane + 64 * j]; s += u[j].x * u[j].x + u[j].y * u[j].y + u[j].z * u[j].z + u[j].w * u[j].w; }
        const float r = 1.0f / sqrtf(wave_sum(s) * (1.0f / D) + EPS);
#pragma unroll
        for (int j = 0; j < 4; ++j) {
            const float4 g = ((const float4*)p.norm2_g)[lane + 64 * j];
            u[j].x *= r * g.x; u[j].y *= r * g.y; u[j].z *= r * g.z; u[j].w *= r * g.w;
            uint2 pk; pk.x = pk2(u[j].x, u[j].y); pk.y = pk2(u[j].z, u[j].w);
            ((uint2*)(u2 + (size_t)t * D))[lane + 64 * j] = pk;
        }
        float mine = 0.f, mx = -1e30f;
#pragma unroll
        for (int e = 0; e < NE; ++e) {
            float a = 0.f;
#pragma unroll
            for (int j = 0; j < 4; ++j) { const pg8::f32x4 w = ((const LAS pg8::f32x4*)(wrT + e * D))[lane + 64 * j]; a += u[j].x * w[0] + u[j].y * w[1] + u[j].z * w[2] + u[j].w * w[3]; }
            a = wave_sum(a);
            mx = fmaxf(mx, a);
            if (lane == e) mine = a;
            asm volatile("" ::: "memory");
        }
        const float ex = (lane < NE) ? expf(mine - mx) : 0.f;
        const float se = wave_sum(ex);
        const int b = t / L, l = t % L;
        if (lane < NE) aff[((size_t)b * NE + lane) * L + l] = ex / se;
    }
    __syncthreads();
}

__device__ __forceinline__ void p6_topk_group(const P& p, LAS unsigned char* lds, int g, int tid, int lane, int wid) {
    LAS unsigned* cnt = (LAS unsigned*)lds; LAS unsigned* wsum = cnt + 8;
    const float* aff = (const float*)(p.ws + WS_AFF) + (size_t)g * L;
    unsigned v[8];
#pragma unroll
    for (int i = 0; i < 8; ++i) v[i] = __builtin_bit_cast(unsigned, aff[tid * 8 + i]);
    unsigned prefix = 0;
    for (int bit = 31; bit >= 0; --bit) {
        const unsigned cand = prefix | (1u << bit);
        unsigned c = 0;
#pragma unroll
        for (int i = 0; i < 8; ++i) c += (v[i] >= cand) ? 1u : 0u;
        c = (unsigned)wave_sum((float)c);
        if (lane == 0) cnt[wid] = c;
        __syncthreads();
        unsigned tot = 0;
#pragma unroll
        for (int w = 0; w < 8; ++w) tot += cnt[w];
        __syncthreads();
        if (tot >= CAP) prefix = cand;
    }
    unsigned ngt = 0, neq = 0;
#pragma unroll
    for (int i = 0; i < 8; ++i) { ngt += v[i] > prefix; neq += v[i] == prefix; }
    unsigned sg = ngt, se = neq;
#pragma unroll
    for (int o = 1; o < 64; o <<= 1) { const unsigned a = __shfl_up(sg, o), c = __shfl_up(se, o); if (lane >= o) { sg += a; se += c; } }
    if (lane == 63) { cnt[wid] = sg; wsum[wid] = se; }
    __syncthreads();
    unsigned og = 0, oe = 0, totg = 0;
#pragma unroll
    for (int w = 0; w < 8; ++w) { if (w < wid) { og += cnt[w]; oe += wsum[w]; } totg += cnt[w]; }
    unsigned pg = og + sg - ngt, pe = oe + se - neq;
    const unsigned need_eq = CAP - totg;
    int* stok = (int*)(p.ws + WS_SELTOK) + g * CAP; float* sgate = (float*)(p.ws + WS_SELGATE) + g * CAP;
    LAS int* ltok = (LAS int*)(lds + 256);
#pragma unroll
    for (int i = 0; i < 8; ++i) {
        if (v[i] > prefix) { stok[pg] = tid * 8 + i; ltok[pg] = tid * 8 + i; sgate[pg] = __builtin_bit_cast(float, v[i]); ++pg; }
        else if (v[i] == prefix) { if (pe < need_eq) { stok[totg + pe] = tid * 8 + i; ltok[totg + pe] = tid * 8 + i; sgate[totg + pe] = __builtin_bit_cast(float, v[i]); } ++pe; }
    }
    __syncthreads();
    const bf16* u2 = (const bf16*)(p.ws + WS_U2) + (size_t)(g >> 4) * L * D; bf16* xin = (bf16*)(p.ws + WS_XIN) + (size_t)g * CAP * D;
    for (int s0 = wid * 64; s0 < wid * 64 + 64; s0 += 8) {
        pg8::u32x4 r0[8], r1[8];
#pragma unroll
        for (int i = 0; i < 8; ++i) { const pg8::u32x4* src = (const pg8::u32x4*)(u2 + (size_t)ltok[s0 + i] * D); r0[i] = src[lane]; r1[i] = src[lane + 64]; }
#pragma unroll
        for (int i = 0; i < 8; ++i) { pg8::u32x4* dst = (pg8::u32x4*)(xin + (size_t)(s0 + i) * D); dst[lane] = r0[i]; dst[lane + 64] = r1[i]; }
    }
    __syncthreads();
}
__device__ __forceinline__ void p6_convert_experts(const P& p, LAS unsigned char* lds, int gw, int NGW, int wave, int lane) {
    LAS float* scr = (LAS float*)(lds + 16384 + wave * 12288);
    constexpr int PER_E = 16 * 64 + 16 * 32;
    for (int it = gw; it < NE * PER_E; it += NGW) {
        const int e = it / PER_E; int r = it % PER_E;
        if (r < 1024) { const int kb = r >> 6, nb = r & 63, rho = nb * 32, bj = (rho >> 7) & 1, f0 = (rho >> 8) * 128 + (rho & 127);
            transpose_item((bj ? p.wu : p.wg) + (size_t)e * D * EH, EH, D, (bf16*)(p.ws + WS_WGU) + (size_t)e * 2048 * D, kb * 64, rho, f0 + (lane & 31), nullptr, scr, lane); }
        else { r -= 1024; const int kb = r >> 5, nb = r & 31;
            transpose_item(p.wd + (size_t)e * EH * D, D, EH, (bf16*)(p.ws + WS_WD) + (size_t)e * D * EH, kb * 64, nb * 32, nb * 32 + (lane & 31), nullptr, scr, lane); }
    }
}

__global__ void __launch_bounds__(NTHR, 2) mega(P p) {
    extern __shared__ __attribute__((aligned(16))) unsigned char lds_raw[];
    LAS unsigned char* lds = (LAS unsigned char*)lds_raw;
    const int tid = threadIdx.x, lane = tid & 63, wave = __builtin_amdgcn_readfirstlane(tid >> 6);
    const int G = gridDim.x, bx = blockIdx.x;
    const int vcu = (G % 8 == 0) ? (bx % 8) * (G / 8) + bx / 8 : bx;
    const int gw = vcu * NWAVES + wave, NGW = G * NWAVES, gt = bx * NTHR + tid, NGT = G * NTHR;
    unsigned char* ws = p.ws;
#define IN(k) (p.ph_lo <= (k) && (k) < p.ph_hi)
    if (IN(0)) p0_prologue(p, lds, gw, NGW, wave, lane, gt, NGT);
    if (IN(1)) {
        pg8::Gemm g{(const bf16*)(ws + WS_XB), (const bf16*)(ws + WS_WINT), (const bf16*)(ws + WS_WINT) + (size_t)3584 * D, (const bf16*)(ws + WS_XB), D};
        pg8::SchedP1 S{G, bx};
        pg8::EpiInProj E{(const float*)(ws + WS_RSTD1), (const float*)(ws + WS_ROPE), p.qng, p.kng, (bf16*)(ws + WS_QN), (bf16*)(ws + WS_KN), (bf16*)(ws + WS_V), (bf16*)(ws + WS_HYT), (bf16*)(ws + WS_GATES)};
        pg8::gemm_phase<pg8::EpiInProj, pg8::SchedP1, true, true>(lds, g, S, E);
    }
    if (IN(2)) {
        const float M2 = static_max_log2(p), lam = calc_lam(p);
        for (int uid = vcu; uid < 512; uid += G) { const int bh = uid >> 5, qb = uid & 31;
            attn::attn_unit(bh >> 2, bh & 3, qb, (const bf16*)(ws + WS_QN), (const bf16*)(ws + WS_KN), (const bf16*)(ws + WS_V), (bf16*)(ws + WS_ATTN), p.subln, M2, lam, lds); }
#if FAST_LEVEL >= 5
#pragma unroll 1
        for (int c = vcu; c < HW; c += G) hy::hyena_channel(p, c, lds, tid);
#endif
    }
    if (IN(3)) {
        pg8::Gemm g{(const bf16*)(ws + WS_ATTN), (const bf16*)(ws + WS_WPA), (const bf16*)(ws + WS_HYENA), (const bf16*)(ws + WS_WPH), 512};
        pg8::SchedP3 S; S.so.init(T, D, G, bx);
        pg8::EpiMerge E{(const bf16*)(ws + WS_GATES), (bf16*)(ws + WS_TMPM), (bf16*)(ws + WS_MERGED)};
        pg8::gemm_phase<pg8::EpiMerge, pg8::SchedP3, true, true>(lds, g, S, E);
    }
    if (IN(4)) {
        pg8::Gemm g{(const bf16*)(ws + WS_MERGED), (const bf16*)(ws + WS_WO), nullptr, nullptr, D};
        pg8::StaticOrder S; S.init(T, D, G, bx);
        pg8::EpiOutProj E{p.x, p.out};
        pg8::gemm_phase<pg8::EpiOutProj, pg8::StaticOrder, true, true>(lds, g, S, E);
    }
    if (IN(5)) p5_router(p, lds, gw, NGW, tid, lane);
    if (IN(6)) {
        if (bx < 64) p6_topk_group(p, lds, bx, tid, lane, wave);
        p6_convert_experts(p, lds, gw, NGW, wave, lane);
    }
    if (IN(7)) {
        pg8::Gemm g{(const bf16*)(ws + WS_XIN), (const bf16*)(ws + WS_WGU), nullptr, nullptr, D};
        pg8::SchedP7 S{G, bx};
        pg8::EpiGateUp E{(bf16*)(ws + WS_HBUF)};
        pg8::gemm_phase<pg8::EpiGateUp, pg8::SchedP7, true, true>(lds, g, S, E);
    }
    if (IN(8)) {
        pg8::Gemm g{(const bf16*)(ws + WS_HBUF), (const bf16*)(ws + WS_WD), nullptr, nullptr, EH};
        pg8::SchedP8 S{G, bx};
        pg8::EpiDown E{(const int*)(ws + WS_SELTOK), (const float*)(ws + WS_SELGATE), p.out};
        pg8::gemm_phase<pg8::EpiDown, pg8::SchedP8, true, true>(lds, g, S, E);
    }
#undef IN
}
__global__ void __launch_bounds__(256) k_attn_naive(P p) {
    __shared__ float sp[2][L];
    __shared__ float qs[2][64];
    __shared__ float red[256];
    const int tid = threadIdx.x; const int l = blockIdx.x % L, h = (blockIdx.x / L) % NH, b = blockIdx.x / (L * NH);
    const bf16* qn = (const bf16*)(p.ws + WS_QN); const bf16* kn = (const bf16*)(p.ws + WS_KN); const bf16* vv = (const bf16*)(p.ws + WS_V);
    if (tid < 128) { const int m = tid >> 6, d = tid & 63; qs[m][d] = bf2f(qn[(((size_t)b * 8 + h * 2 + m) * L + l) * 64 + d]); }
    __syncthreads();
    const float M2 = static_max_log2(p);
    float l1 = 0.f, l2 = 0.f;
    for (int key = tid; key < L; key += 256) {
        for (int m = 0; m < 2; ++m) {
            const bf16* kr = kn + (((size_t)b * 8 + h * 2 + m) * L + key) * 64;
            float s = 0.f;
            for (int d = 0; d < 64; ++d) s += qs[m][d] * bf2f(kr[d]);
            const float e = exp2f(s - M2); sp[m][key] = e; if (m == 0) l1 += e; else l2 += e;
        }
    }
    red[tid] = l1; __syncthreads();
    for (int o = 128; o > 0; o >>= 1) { if (tid < o) red[tid] += red[tid + o]; __syncthreads(); }
    l1 = red[0]; __syncthreads();
    red[tid] = l2; __syncthreads();
    for (int o = 128; o > 0; o >>= 1) { if (tid < o) red[tid] += red[tid + o]; __syncthreads(); }
    l2 = red[0]; __syncthreads();
    const float lam = calc_lam(p);
    const float c1 = 1.0f / l1, c2 = lam / l2;
    const int d = tid & 127, half = tid >> 7;
    float acc = 0.f;
    const bf16* vb = vv + ((size_t)b * NH + h) * L * VD;
    for (int key = half * (L / 2); key < (half + 1) * (L / 2); ++key) acc += (sp[0][key] * c1 - sp[1][key] * c2) * bf2f(vb[(size_t)key * VD + d]);
    red[tid] = acc; __syncthreads();
    float o = 0.f;
    if (tid < 128) { o = red[tid] + red[tid + 128]; }
    __syncthreads();
    red[tid] = (tid < 128) ? o * o : 0.f; __syncthreads();
    for (int s = 128; s > 0; s >>= 1) { if (tid < s) red[tid] += red[tid + s]; __syncthreads(); }
    const float r = 1.0f / sqrtf(red[0] * (1.0f / 128) + EPS);
    if (tid < 128) ((bf16*)(p.ws + WS_ATTN))[(size_t)(b * L + l) * AW + h * VD + tid] = (bf16)f2bf(o * r * p.subln[tid] * (1.0f - LAMBDA_INIT));
}

__global__ void k_hy_kern_naive(P p) {
    const int gid = blockIdx.x * blockDim.x + threadIdx.x;
    if (gid >= 512 * 4 * L) return;
    const int l = gid % L, od = (gid / L) & 3, c = gid / (4 * L);
    const float* hid3 = (const float*)(p.ws + WS_HID3) + l * 64;
    float a = 0.f;
    for (int j = 0; j < 64; ++j) a += hid3[j] * p.fwo[j * 2048 + od * 512 + c];
    const float mind = logf(1e-2f) / 1.5f, maxd = logf(1e-2f) / 0.3f;
    const float delta = fabsf(mind + (maxd - mind) * (float)c / 511.0f);
    const float t = (float)l / (float)(L - 1);
    ((float*)(p.ws + WS_KERNT))[gid] = a * expf(-t * delta);
}
__device__ __forceinline__ float sconv(const P& p, int b, int col, int l) {
    const bf16* h = (const bf16*)(p.ws + WS_HYT) + ((size_t)b * HYC + col) * L;
    float v = bf2f(h[l]) * p.scw[HYC + col] + p.scb[col];
    if (l > 0) v += bf2f(h[l - 1]) * p.scw[col];
    if (l < L - 1) v += bf2f(h[l + 1]) * p.scw[2 * HYC + col];
    return v;
}
__global__ void k_hy_z0_naive(P p) {
    const int gid = blockIdx.x * blockDim.x + threadIdx.x;
    const int l = gid % L, c = (gid / L) % 512, b = gid / (L * 512);
    ((float*)(p.ws + WS_Z0))[gid] = sconv(p, b, c, l);
}
__global__ void k_hy_conv_naive(P p, int order) {
    const int gid = blockIdx.x * blockDim.x + threadIdx.x;
    const int t = gid % L, c = (gid / L) % 512, b = gid / (L * 512);
    const float* zin = (const float*)(p.ws + (order == 0 ? WS_Z0 : WS_Z1)) + ((size_t)b * 512 + c) * L;
    const float* kf = (const float*)(p.ws + WS_KERNT) + ((size_t)(c * 2 + order) * 2 + 0) * L;
    const float* kb = kf + L;
    float acc = 0.f;
    for (int s = 0; s <= t; ++s) acc += kf[t - s] * zin[s];
    for (int s = t + 1; s < L; ++s) acc += kb[s - t] * zin[s];
    const float g = sconv(p, b, 512 * (order + 1) + c, t);
    const float z = g * (acc + p.hskip[order * 512 + c] * zin[t]);
    if (order == 0) ((float*)(p.ws + WS_Z1))[gid] = z;
    else ((bf16*)(p.ws + WS_HYENA))[(size_t)(b * L + t) * HW + c] = (bf16)f2bf(z);
}

__global__ void k_merge_naive(P p) {
    const int n = blockIdx.x * 256 + threadIdx.x, t0 = blockIdx.y * 8;
    float a1[8], a2[8];
    for (int i = 0; i < 8; ++i) { a1[i] = 0.f; a2[i] = 0.f; }
    const bf16* at = (const bf16*)(p.ws + WS_ATTN); const bf16* hy = (const bf16*)(p.ws + WS_HYENA);
    for (int k = 0; k < 512; ++k) {
        const float w1 = p.wpa[(size_t)k * D + n], w2 = p.wph[(size_t)k * D + n];
        for (int i = 0; i < 8; ++i) { a1[i] += bf2f(at[(size_t)(t0 + i) * AW + k]) * w1; a2[i] += bf2f(hy[(size_t)(t0 + i) * HW + k]) * w2; }
    }
    const bf16* g = (const bf16*)(p.ws + WS_GATES);
    for (int i = 0; i < 8; ++i) { const int t = t0 + i; const float v = bf2f(g[(size_t)t * GC + n]) * a1[i] + bf2f(g[(size_t)t * GC + 1024 + n]) * a2[i];
        ((bf16*)(p.ws + WS_MERGED))[(size_t)t * D + n] = (bf16)f2bf(v); }
}
__global__ void k_outproj_naive(P p) {
    const int n = blockIdx.x * 256 + threadIdx.x, t0 = blockIdx.y * 8;
    float a[8];
    for (int i = 0; i < 8; ++i) a[i] = 0.f;
    const bf16* m = (const bf16*)(p.ws + WS_MERGED);
    for (int k = 0; k < D; ++k) { const float w = p.wo[(size_t)k * D + n]; for (int i = 0; i < 8; ++i) a[i] += bf2f(m[(size_t)(t0 + i) * D + k]) * w; }
    for (int i = 0; i < 8; ++i) { const size_t o = (size_t)(t0 + i) * D + n; p.out[o] = p.x[o] + a[i]; }
}

__global__ void k_moe_h_naive(P p) {
    const int f = blockIdx.x * 256 + threadIdx.x, r0 = blockIdx.y * 8, g = blockIdx.z, b = g >> 4, e = g & 15;
    const int* stok = (const int*)(p.ws + WS_SELTOK) + g * CAP;
    const bf16* u2 = (const bf16*)(p.ws + WS_U2);
    const bf16* rows[8];
    for (int i = 0; i < 8; ++i) rows[i] = u2 + (size_t)(b * L + stok[r0 + i]) * D;
    float ag[8], au[8];
    for (int i = 0; i < 8; ++i) { ag[i] = 0.f; au[i] = 0.f; }
    const float* wg = p.wg + (size_t)e * D * EH; const float* wu = p.wu + (size_t)e * D * EH;
    for (int k = 0; k < D; ++k) { const float w1 = wg[(size_t)k * EH + f], w2 = wu[(size_t)k * EH + f];
        for (int i = 0; i < 8; ++i) { const float a = bf2f(rows[i][k]); ag[i] += a * w1; au[i] += a * w2; } }
    bf16* hb = (bf16*)(p.ws + WS_HBUF);
    for (int i = 0; i < 8; ++i) { const float s = ag[i] / (1.0f + expf(-ag[i])); hb[((size_t)g * CAP + r0 + i) * EH + f] = (bf16)f2bf(s * au[i]); }
}
__global__ void k_moe_down_naive(P p) {
    const int n = blockIdx.x * 256 + threadIdx.x, r0 = blockIdx.y * 8, g = blockIdx.z, b = g >> 4, e = g & 15;
    const int* stok = (const int*)(p.ws + WS_SELTOK) + g * CAP; const float* sgate = (const float*)(p.ws + WS_SELGATE) + g * CAP;
    const bf16* hb = (const bf16*)(p.ws + WS_HBUF) + ((size_t)g * CAP + r0) * EH;
    float a[8];
    for (int i = 0; i < 8; ++i) a[i] = 0.f;
    const float* wd = p.wd + (size_t)e * EH * D;
    for (int k = 0; k < EH; ++k) { const float w = wd[(size_t)k * D + n]; for (int i = 0; i < 8; ++i) a[i] += bf2f(hb[(size_t)i * EH + k]) * w; }
    for (int i = 0; i < 8; ++i) atomicAdd(&p.out[(size_t)(b * L + stok[r0 + i]) * D + n], a[i] * sgate[r0 + i]);
}


extern "C" void kernel_launch(void* const* d_in, const int* in_sizes, int n_in, void* d_out, int out_size, void* d_ws, size_t ws_size, hipStream_t stream) {
    static int ok = 0;
    if (ok == 0) {
        if (n_in != 29 || ws_size < WS_END) { fprintf(stderr, "kernel_launch: bad args n_in=%d ws=%zu\n", n_in, ws_size); ok = -1; return; }
        if (hipFuncSetAttribute((const void*)mega, hipFuncAttributeMaxDynamicSharedMemorySize, LDS_BYTES) != hipSuccess) { fprintf(stderr, "hipFuncSetAttribute failed\n"); ok = -1; return; }
        ok = 1;
    }
    if (ok < 0) return;
    P p{};
    const float** f = (const float**)&p;
    for (int i = 0; i < 29; ++i) f[i] = (const float*)d_in[i];
    p.out = (float*)d_out; p.ws = (unsigned char*)d_ws;
    (void)hipMemsetAsync((char*)d_ws + WS_CTL, 0, 1 * MiB, stream);
#define MEGA(lo, hi) do { p.ph_lo = (lo); p.ph_hi = (hi); hipLaunchKernelGGL(mega, dim3(256), dim3(NTHR), LDS_BYTES, stream, p); } while (0)
    MEGA(0, 1);
    MEGA(1, 2);
#if FAST_LEVEL >= 4
    MEGA(2, 3);
#else
    k_attn_naive<<<Bn * NH * L, 256, 0, stream>>>(p);
#endif
#if FAST_LEVEL < 5
    k_hy_kern_naive<<<512 * 4 * L / 256, 256, 0, stream>>>(p);
    k_hy_z0_naive<<<Bn * 512 * L / 256, 256, 0, stream>>>(p);
    k_hy_conv_naive<<<Bn * 512 * L / 256, 256, 0, stream>>>(p, 0);
    k_hy_conv_naive<<<Bn * 512 * L / 256, 256, 0, stream>>>(p, 1);
#endif
#if FAST_LEVEL >= 2
    MEGA(3, 4);
    MEGA(4, 5);
#else
    k_merge_naive<<<dim3(D / 256, T / 8), 256, 0, stream>>>(p);
    k_outproj_naive<<<dim3(D / 256, T / 8), 256, 0, stream>>>(p);
#endif
    MEGA(5, 6);
    MEGA(6, 7);
#if FAST_LEVEL >= 3
    MEGA(7, 8);
    MEGA(8, 9);
#else
    k_moe_h_naive<<<dim3(EH / 256, CAP / 8, 64), 256, 0, stream>>>(p);
    k_moe_down_naive<<<dim3(D / 256, CAP / 8, 64), 256, 0, stream>>>(p);
#endif
}
```

```cpp
#include <hip/hip_runtime.h>
#include <hip/hip_cooperative_groups.h>
#include <cstdio>
#include <cstdint>
#include <cmath>

#ifndef ONE_LAUNCH
#define ONE_LAUNCH 1
#endif
#ifndef FAST_LEVEL
#define FAST_LEVEL 5
#endif
constexpr int Bn = 4, L = 4096, D = 1024, T = Bn * L;
constexpr int NH = 4, QK = 64, VD = 128, AW = 512;
constexpr int HW = 512, HYC = 1536, GC = 2048, INC = 5120;
constexpr int NE = 16, CAP = 512, EH = 1024;
constexpr float EPS = 1e-6f;
constexpr float LAMBDA_INIT = 0.2f;
constexpr float QSCALE = 0.125f * 1.4426950408889634f;

typedef unsigned short bf16;
__device__ __forceinline__ unsigned f2bf(float f) { unsigned u = __builtin_bit_cast(unsigned, f); return (u + 0x7fffu + ((u >> 16) & 1u)) >> 16; }
__device__ __forceinline__ float bf2f(bf16 h) { return __builtin_bit_cast(float, (unsigned)h << 16); }
__device__ __forceinline__ unsigned pk2(float lo, float hi) { return f2bf(lo) | (f2bf(hi) << 16); }
__device__ __forceinline__ float bflo(unsigned w) { return __builtin_bit_cast(float, w << 16); }
__device__ __forceinline__ float bfhi(unsigned w) { return __builtin_bit_cast(float, w & 0xffff0000u); }

constexpr size_t MiB = 1u << 20;
constexpr size_t WS_CTL = 0;
constexpr size_t WS_RSTD1 = 1 * MiB;
constexpr size_t WS_ROPE = 1 * MiB + 256 * 1024;
constexpr size_t WS_SELTOK = 1 * MiB + 512 * 1024;
constexpr size_t WS_SELGATE = 1 * MiB + 768 * 1024;
constexpr size_t WS_HID3 = 2 * MiB;
constexpr size_t WS_AFF = 3 * MiB;
constexpr size_t WS_WINT = 4 * MiB;
constexpr size_t WS_WPA = 15 * MiB, WS_WPH = 16 * MiB, WS_WO = 17 * MiB;
constexpr size_t WS_XB = 19 * MiB;
constexpr size_t WS_QN = 51 * MiB, WS_KN = 67 * MiB, WS_V = 83 * MiB;
constexpr size_t WS_HYT = 99 * MiB;
constexpr size_t WS_GATES = 147 * MiB;
constexpr size_t WS_ATTN = 211 * MiB, WS_HYENA = 227 * MiB;
constexpr size_t WS_TMPM = 19 * MiB, WS_MERGED = 51 * MiB;
constexpr size_t WS_U2 = 83 * MiB;
constexpr size_t WS_WGU = 115 * MiB, WS_WD = 179 * MiB;
constexpr size_t WS_XIN = 211 * MiB;
constexpr size_t WS_HBUF = 19 * MiB;
constexpr size_t WS_END = 275 * MiB;
constexpr size_t WS_KERNT = 19 * MiB;
constexpr size_t WS_Z0 = 243 * MiB;
constexpr size_t WS_Z1 = 51 * MiB;

struct P {
    const float *x, *norm1_g, *w_in, *scw, *scb, *qng, *kng, *lq1, *lk1, *lq2, *lk2, *subln, *fw1, *fb1, *fw2, *fb2, *fw3, *fb3, *fwo, *ffreq, *hskip, *wpa, *wph, *wo, *norm2_g, *wr, *wg, *wu, *wd;
    float* out; unsigned char* ws;
    int ph_lo, ph_hi;
};

__device__ __forceinline__ float wave_sum(float v) {
#pragma unroll
    for (int o = 1; o < 64; o <<= 1) v += __shfl_xor(v, o);
    return v;
}
__device__ __forceinline__ float static_max_log2(const P& p) {
    float mq = 0.f, mk = 0.f;
    for (int d = 0; d < 64; ++d) { mq = fmaxf(mq, fabsf(p.qng[d])); mk = fmaxf(mk, fabsf(p.kng[d])); }
    return 8.0f * mq * mk * 1.4426950408889634f * 1.01f + 0.05f;
}
__device__ __forceinline__ float calc_lam(const P& p) {
    float a = 0.f, c = 0.f;
    for (int d = 0; d < 64; ++d) { a += p.lq1[d] * p.lk1[d]; c += p.lq2[d] * p.lk2[d]; }
    return expf(a) - expf(c) + LAMBDA_INIT;
}
namespace pg8 {
#define PG8_LAS __attribute__((address_space(3)))
typedef unsigned short bf16_t;
typedef short bf16x8 __attribute__((ext_vector_type(8)));
typedef float f32x4 __attribute__((ext_vector_type(4)));
typedef unsigned u32x4 __attribute__((ext_vector_type(4)));
constexpr int BM = 256, BK = 64, HALF = 128, HTB = HALF * BK * 2  , STAGE_BYTES = 8 * HTB, NXCD = 8, WGM = 8;

__host__ __device__ __forceinline__ int lds_byte(int r, int c) { const int st = (r >> 4) * 2 + (c >> 5), rr = r & 15, cc = c & 31, ob = rr * 64 + cc * 2; return st * 1024 + (ob ^ (((ob >> 9) & 1) << 5)); }
__host__ __device__ __forceinline__ void stage_rc(int b, int& R, int& C) { const int st = b / 1024, sb = b % 1024, swz = sb ^ (((sb >> 9) & 1) << 5); R = (st >> 1) * 16 + swz / 64; C = (st & 1) * 32 + (swz % 64) / 2; }
__host__ __device__ __forceinline__ int perm32(int rho) { const int n = rho >> 4, i = rho & 15; return 8 * (i >> 2) + 4 * n + (i & 3); }

struct Unit { int pm, pn, kind; };
struct Gemm { const bf16_t* A0; const bf16_t* B0; const bf16_t* A1; const bf16_t* B1; int K; };

struct StaticOrder {
    int nM, nN, nwg, G, c;
    __host__ __device__ void init(int M, int N, int G_, int c_) { nM = M / BM; nN = N / BM; nwg = nM * nN; G = G_; c = c_; }
    __host__ __device__ bool next(int i, Unit& u) const {
        const long L = (long)i * G + c; if (L >= nwg) return false;
        int wgid = (int)L; { const int q = nwg / NXCD, r = nwg % NXCD, xcd = wgid % NXCD, off = wgid / NXCD; wgid = (xcd < r ? xcd * (q + 1) : r * (q + 1) + (xcd - r) * q) + off; }
        const int nig = WGM * nN, gid = wgid / nig, fm = gid * WGM, gsz = (nM - fm) < WGM ? (nM - fm) : WGM;
        u.pm = fm + ((wgid % nig) % gsz); u.pn = (wgid % nig) / gsz; u.kind = 0; return true;
    }
    __device__ __forceinline__ void a_ready(const Unit&) const {}
    __device__ __forceinline__ void done(const Unit&) const {}
};

template <class Epi, class Sched, bool ALIGN_EPI = false, bool SP2 = false>
__device__ __forceinline__ void gemm_phase(PG8_LAS unsigned char* lds, const Gemm g, const Sched& S, const Epi& E) {
    const int tid = threadIdx.x, wid = __builtin_amdgcn_readfirstlane(tid >> 6), lane = tid & 63, wr = wid >> 2, wc = wid & 3, fr = lane & 15, fq = lane >> 4;
    const int K = g.K, nt = K / BK;
    unsigned voffA[2], voffB[2];
#pragma unroll
    for (int i = 0; i < 2; ++i) { int R, C; stage_rc(tid * 16 + i * 8192, R, C); const int Rb = Epi::PERM ? ((R & ~31) + perm32(R & 31)) : R;
        voffA[i] = (unsigned)(R * K + C) * 2u; voffB[i] = (unsigned)(Rb * K + C) * 2u; }
    const size_t kstep = (size_t)(BK * 2);
    const size_t hstep = (size_t)HALF * K * 2;
    const size_t tstep = 2 * hstep;
    const unsigned ldsw = (unsigned)wid * 1024u;
    const int aoff = lds_byte(wr * 64 + fr, fq * 8), boff = lds_byte(wc * 32 + fr, fq * 8);
#define PG8_SA(b, h) (((b) * 2 + (h)) * HTB)
#define PG8_SB(b, h) ((4 + (b) * 2 + (h)) * HTB)
#define PG8_STAGE(bufoff, gbase, voff) do { _Pragma("unroll") for (int _i = 0; _i < 2; ++_i) \
        __builtin_amdgcn_global_load_lds((const unsigned*)((const char*)(gbase) + (voff)[_i]), (PG8_LAS unsigned*)(lds + (bufoff) + ldsw + _i * 8192), 16, 0, 0); } while (0)
#define PG8_LDA(dst, b, h) do { _Pragma("unroll") for (int m = 0; m < 4; ++m) _Pragma("unroll") for (int k = 0; k < 2; ++k) dst[m][k] = *(const PG8_LAS bf16x8*)(lds + PG8_SA(b, h) + aoff + m * 2048 + k * 1024); } while (0)
#define PG8_LDB(dst, b, h) do { _Pragma("unroll") for (int n = 0; n < 2; ++n) _Pragma("unroll") for (int k = 0; k < 2; ++k) dst[n][k] = *(const PG8_LAS bf16x8*)(lds + PG8_SB(b, h) + boff + n * 2048 + k * 1024); } while (0)
#define PG8_MMA(ai, bj, At, Bt) do { __builtin_amdgcn_s_setprio(1); _Pragma("unroll") for (int m = 0; m < 4; ++m) _Pragma("unroll") for (int n = 0; n < 2; ++n) _Pragma("unroll") for (int k = 0; k < 2; ++k) \
        acc[ai][bj][m][n] = __builtin_amdgcn_mfma_f32_16x16x32_bf16(Bt[n][k], At[m][k], acc[ai][bj][m][n], 0, 0, 0); __builtin_amdgcn_s_setprio(0); } while (0)
#define PG8_WAIT_V(n) asm volatile("s_waitcnt vmcnt(" #n ")" ::: "memory")
#define PG8_WAIT_L(n) asm volatile("s_waitcnt lgkmcnt(" #n ")" ::: "memory")
#define PG8_BAR __builtin_amdgcn_s_barrier()
#define PG8_SCHED __builtin_amdgcn_sched_barrier(0)
    Unit cur, nxt; int ui = 0;
    if (!S.next(0, cur)) return;
    f32x4 acc[2][2][4][2];
#pragma unroll
    for (int a = 0; a < 2; ++a)
#pragma unroll
        for (int b = 0; b < 2; ++b)
#pragma unroll
            for (int m = 0; m < 4; ++m)
#pragma unroll
                for (int n = 0; n < 2; ++n) acc[a][b][m][n] = (f32x4){0.f, 0.f, 0.f, 0.f};
    bf16x8 At[4][2], B0[2][2], B1[2][2];
    const char* cA = (const char*)(cur.kind ? g.A1 : g.A0) + (size_t)cur.pm * tstep; const char* cB = (const char*)(cur.kind ? g.B1 : g.B0) + (size_t)cur.pn * tstep;
    S.a_ready(cur);
    if constexpr (SP2) {
        PG8_STAGE(PG8_SB(0, 0), cB, voffB); PG8_STAGE(PG8_SB(0, 1), cB + hstep, voffB); PG8_STAGE(PG8_SA(0, 0), cA, voffA); PG8_STAGE(PG8_SA(0, 1), cA + hstep, voffA);
        if (wr == 1) PG8_BAR;
        PG8_WAIT_V(2); PG8_BAR;
        PG8_STAGE(PG8_SB(1, 0), cB + kstep, voffB); PG8_STAGE(PG8_SA(1, 0), cA + kstep, voffA); PG8_STAGE(PG8_SB(1, 1), cB + hstep + kstep, voffB);
        PG8_WAIT_V(6); PG8_BAR;
    } else {
        PG8_STAGE(PG8_SB(0, 0), cB, voffB); PG8_STAGE(PG8_SA(0, 0), cA, voffA); PG8_STAGE(PG8_SB(0, 1), cB + hstep, voffB); PG8_STAGE(PG8_SA(0, 1), cA + hstep, voffA);
        if (wr == 1) PG8_BAR;
        PG8_WAIT_V(4); PG8_BAR;
        PG8_STAGE(PG8_SB(1, 0), cB + kstep, voffB); PG8_STAGE(PG8_SA(1, 0), cA + kstep, voffA); PG8_STAGE(PG8_SB(1, 1), cB + hstep + kstep, voffB);
        PG8_WAIT_V(6); PG8_BAR;
    }
    for (;;) {
        const bool has_next = S.next(ui + 1, nxt);
        const char* nA = has_next ? (const char*)(nxt.kind ? g.A1 : g.A0) + (size_t)nxt.pm * tstep : cA; const char* nB = has_next ? (const char*)(nxt.kind ? g.B1 : g.B0) + (size_t)nxt.pn * tstep : cB;
        for (int t = 0; t < nt; t += 2) {
            const bool last = (t == nt - 2);
            const char* a1 = cA + (size_t)(t + 1) * kstep;
            const char* a2 = last ? nA : cA + (size_t)(t + 2) * kstep; const char* b2 = last ? nB : cB + (size_t)(t + 2) * kstep;
            const char* a3 = a2 + kstep; const char* b3 = b2 + kstep;
            if (last && has_next) S.a_ready(nxt);
            if constexpr (SP2) {
            PG8_LDB(B0, 0, 0); PG8_LDB(B1, 0, 1); PG8_SCHED; PG8_LDA(At, 0, 0); PG8_STAGE(PG8_SA(1, 1), a1 + hstep, voffA);
            PG8_WAIT_V(8); PG8_WAIT_L(0); PG8_BAR; PG8_MMA(0, 0, At, B0); PG8_MMA(0, 1, At, B1); PG8_BAR; PG8_SCHED;
            PG8_LDA(At, 0, 1); PG8_STAGE(PG8_SB(0, 0), b2, voffB); PG8_STAGE(PG8_SB(0, 1), b2 + hstep, voffB); PG8_STAGE(PG8_SA(0, 0), a2, voffA);
            PG8_WAIT_V(8); PG8_WAIT_L(0); PG8_BAR; PG8_MMA(1, 0, At, B0); PG8_MMA(1, 1, At, B1); PG8_BAR; PG8_SCHED;
            PG8_LDB(B0, 1, 0); PG8_LDB(B1, 1, 1); PG8_SCHED; PG8_LDA(At, 1, 0); PG8_STAGE(PG8_SA(0, 1), a2 + hstep, voffA);
            PG8_WAIT_V(8); PG8_WAIT_L(0); PG8_BAR; PG8_MMA(0, 0, At, B0); PG8_MMA(0, 1, At, B1); PG8_BAR; PG8_SCHED;
            PG8_LDA(At, 1, 1); PG8_STAGE(PG8_SB(1, 0), b3, voffB); PG8_STAGE(PG8_SB(1, 1), b3 + hstep, voffB); PG8_STAGE(PG8_SA(1, 0), a3, voffA);
            PG8_WAIT_V(8); PG8_WAIT_L(0); PG8_BAR; PG8_MMA(1, 0, At, B0); PG8_MMA(1, 1, At, B1); PG8_BAR; PG8_SCHED;
            } else {
            PG8_LDB(B0, 0, 0); PG8_SCHED; PG8_LDA(At, 0, 0); PG8_STAGE(PG8_SA(1, 1), a1 + hstep, voffA);
            PG8_WAIT_L(8); PG8_BAR; PG8_WAIT_L(0); PG8_MMA(0, 0, At, B0); PG8_BAR; PG8_SCHED;
            PG8_LDB(B1, 0, 1); PG8_STAGE(PG8_SB(0, 0), b2, voffB);
            PG8_BAR; PG8_WAIT_L(0); PG8_MMA(0, 1, At, B1); PG8_BAR;
            PG8_LDA(At, 0, 1); PG8_STAGE(PG8_SA(0, 0), a2, voffA);
            PG8_BAR; PG8_WAIT_L(0); PG8_MMA(1, 0, At, B0); PG8_BAR; PG8_SCHED;
            PG8_STAGE(PG8_SB(0, 1), b2 + hstep, voffB);
            PG8_WAIT_V(6); PG8_BAR; PG8_MMA(1, 1, At, B1); PG8_BAR;
            PG8_LDB(B0, 1, 0); PG8_SCHED; PG8_LDA(At, 1, 0); PG8_STAGE(PG8_SA(0, 1), a2 + hstep, voffA);
            PG8_WAIT_L(8); PG8_BAR; PG8_WAIT_L(0); PG8_MMA(0, 0, At, B0); PG8_BAR; PG8_SCHED;
            PG8_LDB(B1, 1, 1); PG8_STAGE(PG8_SB(1, 0), b3, voffB);
            PG8_BAR; PG8_WAIT_L(0); PG8_MMA(0, 1, At, B1); PG8_BAR;
            PG8_LDA(At, 1, 1); PG8_STAGE(PG8_SA(1, 0), a3, voffA);
            PG8_BAR; PG8_WAIT_L(0); PG8_MMA(1, 0, At, B0); PG8_BAR; PG8_SCHED;
            PG8_STAGE(PG8_SB(1, 1), b3 + hstep, voffB);
            PG8_WAIT_V(6); PG8_BAR; PG8_MMA(1, 1, At, B1); PG8_BAR;
            }
        }
        if constexpr (ALIGN_EPI) { if (wr == 0) PG8_BAR; }
        if constexpr (!Epi::AFTER_DRAIN) { E(acc, cur, wr, wc, fr, fq); S.done(cur); }
        if (!has_next) break;
#pragma unroll
        for (int a = 0; a < 2; ++a)
#pragma unroll
            for (int b = 0; b < 2; ++b)
#pragma unroll
                for (int m = 0; m < 4; ++m)
#pragma unroll
                    for (int n = 0; n < 2; ++n) acc[a][b][m][n] = (f32x4){0.f, 0.f, 0.f, 0.f};
        cur = nxt; cA = nA; cB = nB; ++ui;
        if constexpr (ALIGN_EPI) { if (wr == 1) PG8_BAR; }
    }
    PG8_WAIT_V(0);
    if constexpr (!ALIGN_EPI) { if (wr == 0) PG8_BAR; }
    PG8_BAR;
    if constexpr (Epi::AFTER_DRAIN) { E.fused(acc, cur, wr, wc, fr, fq, lds, wid, lane); S.done(cur); }
#undef PG8_SA
#undef PG8_SB
#undef PG8_STAGE
#undef PG8_LDA
#undef PG8_LDB
#undef PG8_MMA
#undef PG8_WAIT_V
#undef PG8_WAIT_L
#undef PG8_BAR
#undef PG8_SCHED
}
}
namespace pg8 {
typedef unsigned u32x2 __attribute__((ext_vector_type(2)));
__device__ __forceinline__ unsigned xcd_remap(int L_, int nwg) { const int q = nwg / NXCD, r = nwg % NXCD, xcd = L_ % NXCD, off = L_ / NXCD; return (unsigned)((xcd < r ? xcd * (q + 1) : r * (q + 1) + (xcd - r) * q) + off); }

struct SchedP1 {
    int G, c;
    __device__ bool next(int i, Unit& u) const {
        const int Lx = i * G + c; if (Lx >= 1280) return false;
        if (Lx < 896) { const int wgid = (int)xcd_remap(Lx, 896); const int nig = 8 * 14, gid = wgid / nig, fm = gid * 8; u.pm = fm + ((wgid % nig) % 8); u.pn = (wgid % nig) / 8; u.kind = 0; }
        else { const int wgid = (int)xcd_remap(Lx - 896, 384); u.pm = wgid % 6; u.pn = wgid / 6; u.kind = 1; }
        return true;
    }
    __device__ __forceinline__ void a_ready(const Unit&) const {}
    __device__ __forceinline__ void done(const Unit&) const {}
};
struct EpiInProj {
    static constexpr bool PERM = true, AFTER_DRAIN = false;
    const float* rstd1; const float* rope; const float* gq; const float* gk;
    bf16_t *qn, *kn, *v, *hyT, *gates;
    __device__ __forceinline__ void operator()(const f32x4 (&acc)[2][2][4][2], const Unit& u, int wr, int wc, int fr, int fq) const {
        if (u.kind == 1) {
            const int tok0 = u.pn * BM, b = tok0 / L, l0 = tok0 % L;
            f32x4 rs[2][2];
#pragma unroll
            for (int bj = 0; bj < 2; ++bj)
#pragma unroll
                for (int n = 0; n < 2; ++n) rs[bj][n] = *(const f32x4*)(rstd1 + tok0 + bj * HALF + wc * 32 + 8 * fq + 4 * n);
#pragma unroll
            for (int ai = 0; ai < 2; ++ai)
#pragma unroll
                for (int m = 0; m < 4; ++m) {
                    const int r = u.pm * BM + ai * HALF + wr * 64 + m * 16 + fr;
                    bf16_t* rowp = hyT + ((size_t)b * HYC + r) * L + l0 + wc * 32 + 8 * fq;
#pragma unroll
                    for (int bj = 0; bj < 2; ++bj) { const f32x4 v0 = acc[ai][bj][m][0] * rs[bj][0], v1 = acc[ai][bj][m][1] * rs[bj][1];
                        u32x4 w; w.x = pk2(v0[0], v0[1]); w.y = pk2(v0[2], v0[3]); w.z = pk2(v1[0], v1[1]); w.w = pk2(v1[2], v1[3]);
                        *(u32x4*)(rowp + bj * HALF) = w; }
                }
            return;
        }
        const int row0 = u.pm * BM + wr * 64 + fr;
        if (u.pn < 4) {
            const int gidx = u.pn * 4 + wc, hm = gidx & 7; const bool isq = gidx < 8;
            const float* gain = isq ? gq : gk; bf16_t* dst = isq ? qn : kn;
            float gp[2][8];
#pragma unroll
            for (int bj = 0; bj < 2; ++bj)
#pragma unroll
                for (int t = 0; t < 8; ++t) { const int d = (bj == 0 && fq < 2) ? (4 * fq + (t >> 1) + 8 * (t & 1)) : (32 * bj + 8 * fq + t); gp[bj][t] = gain[d]; }
            const float sc = isq ? QSCALE : 1.0f;
#pragma unroll
            for (int ai = 0; ai < 2; ++ai)
#pragma unroll
                for (int m = 0; m < 4; ++m) {
                    const int tok = row0 + ai * HALF + m * 16, b = tok / L, l = tok % L;
                    const float rr = rstd1[tok];
                    float y[2][8]; float ss = 0.f;
#pragma unroll
                    for (int bj = 0; bj < 2; ++bj)
#pragma unroll
                        for (int t = 0; t < 8; ++t) { y[bj][t] = acc[ai][bj][m][t >> 2][t & 3] * rr; ss += y[bj][t] * y[bj][t]; }
                    ss += __shfl_xor(ss, 16); ss += __shfl_xor(ss, 32);
                    const float rn = 1.0f / sqrtf(ss * (1.0f / 64) + EPS);
#pragma unroll
                    for (int bj = 0; bj < 2; ++bj)
#pragma unroll
                        for (int t = 0; t < 8; ++t) y[bj][t] *= rn * gp[bj][t];
                    if (fq < 2) {
                        const f32x4 cs = *(const f32x4*)(rope + l * 8 + 4 * fq), sn = *(const f32x4*)(rope + L * 8 + l * 8 + 4 * fq);
#pragma unroll
                        for (int j = 0; j < 4; ++j) { const float a = y[0][2 * j], c = y[0][2 * j + 1]; y[0][2 * j] = a * cs[j] - c * sn[j]; y[0][2 * j + 1] = c * cs[j] + a * sn[j]; }
                    }
                    bf16_t* rowp = dst + (((size_t)b * 8 + hm) * L + l) * 64 + 8 * fq;
#pragma unroll
                    for (int bj = 0; bj < 2; ++bj) { u32x4 w; w.x = pk2(y[bj][0] * sc, y[bj][1] * sc); w.y = pk2(y[bj][2] * sc, y[bj][3] * sc); w.z = pk2(y[bj][4] * sc, y[bj][5] * sc); w.w = pk2(y[bj][6] * sc, y[bj][7] * sc);
                        *(u32x4*)(rowp + 32 * bj) = w; }
                }
        } else if (u.pn < 6) {
#pragma unroll
            for (int ai = 0; ai < 2; ++ai)
#pragma unroll
                for (int m = 0; m < 4; ++m) {
                    const int tok = row0 + ai * HALF + m * 16, b = tok / L, l = tok % L; const float rr = rstd1[tok];
#pragma unroll
                    for (int bj = 0; bj < 2; ++bj) { const f32x4 v0 = acc[ai][bj][m][0] * rr, v1 = acc[ai][bj][m][1] * rr;
                        u32x4 w; w.x = pk2(v0[0], v0[1]); w.y = pk2(v0[2], v0[3]); w.z = pk2(v1[0], v1[1]); w.w = pk2(v1[2], v1[3]);
                        *(u32x4*)(v + (((size_t)b * NH + (u.pn - 4) * 2 + bj) * L + l) * VD + 32 * wc + 8 * fq) = w; }
                }
        } else {
#pragma unroll
            for (int ai = 0; ai < 2; ++ai)
#pragma unroll
                for (int m = 0; m < 4; ++m) {
                    const int tok = row0 + ai * HALF + m * 16; const float rr = rstd1[tok];
#pragma unroll
                    for (int bj = 0; bj < 2; ++bj) { float s[8];
#pragma unroll
                        for (int t = 0; t < 8; ++t) s[t] = __builtin_amdgcn_rcpf(1.0f + __builtin_amdgcn_exp2f(-1.4426950408889634f * rr * acc[ai][bj][m][t >> 2][t & 3]));
                        u32x4 w; w.x = pk2(s[0], s[1]); w.y = pk2(s[2], s[3]); w.z = pk2(s[4], s[5]); w.w = pk2(s[6], s[7]);
                        *(u32x4*)(gates + (size_t)tok * GC + (u.pn - 6) * BM + bj * HALF + wc * 32 + 8 * fq) = w; }
                }
        }
    }
};

struct SchedP3 {
    StaticOrder so;
    __device__ bool next(int i, Unit& u) const { if (i >= 2) return false; so.next(0, u); u.kind = i; return true; }
    __device__ __forceinline__ void a_ready(const Unit&) const {}
    __device__ __forceinline__ void done(const Unit&) const {}
};
struct EpiMerge {
    static constexpr bool PERM = true, AFTER_DRAIN = false;
    const bf16_t* gates; bf16_t* tmpm; bf16_t* merged;
    __device__ __forceinline__ void operator()(const f32x4 (&acc)[2][2][4][2], const Unit& u, int wr, int wc, int fr, int fq) const {
        const int row0 = u.pm * BM + wr * 64 + fr, col0 = u.pn * BM + wc * 32 + 8 * fq;
#pragma unroll
        for (int ai = 0; ai < 2; ++ai)
#pragma unroll
            for (int m = 0; m < 4; ++m) {
                const int tok = row0 + ai * HALF + m * 16;
#pragma unroll
                for (int bj = 0; bj < 2; ++bj) {
                    const int col = col0 + bj * HALF;
                    const u32x4 g = *(const u32x4*)(gates + (size_t)tok * GC + u.kind * 1024 + col);
                    float o[8];
#pragma unroll
                    for (int t = 0; t < 4; ++t) { o[2 * t] = bflo(g[t]) * acc[ai][bj][m][t >> 1][(2 * t) & 3]; o[2 * t + 1] = bfhi(g[t]) * acc[ai][bj][m][t >> 1][(2 * t + 1) & 3]; }
                    if (u.kind == 1) { const u32x4 pr = *(const u32x4*)(tmpm + (size_t)tok * D + col);
#pragma unroll
                        for (int t = 0; t < 4; ++t) { o[2 * t] += bflo(pr[t]); o[2 * t + 1] += bfhi(pr[t]); } }
                    u32x4 w; w.x = pk2(o[0], o[1]); w.y = pk2(o[2], o[3]); w.z = pk2(o[4], o[5]); w.w = pk2(o[6], o[7]);
                    *(u32x4*)((u.kind == 1 ? merged : tmpm) + (size_t)tok * D + col) = w;
                }
            }
    }
};

struct EpiOutProj {
    static constexpr bool PERM = false, AFTER_DRAIN = false;
    const float* x; float* out;
    __device__ __forceinline__ void operator()(const f32x4 (&acc)[2][2][4][2], const Unit& u, int wr, int wc, int fr, int fq) const {
        const int row0 = u.pm * BM + wr * 64 + fr, col0 = u.pn * BM + wc * 32 + 4 * fq;
#pragma unroll
        for (int ai = 0; ai < 2; ++ai)
#pragma unroll
            for (int m = 0; m < 4; ++m) { const size_t off = (size_t)(row0 + ai * HALF + m * 16) * D + col0;
#pragma unroll
                for (int bj = 0; bj < 2; ++bj)
#pragma unroll
                    for (int n = 0; n < 2; ++n) { const f32x4 xv = *(const f32x4*)(x + off + bj * HALF + n * 16); *(f32x4*)(out + off + bj * HALF + n * 16) = xv + acc[ai][bj][m][n]; } }
    }
};

struct SchedP7 {
    int G, c;
    __device__ bool next(int i, Unit& u) const {
        const int Lx = i * G + c; if (Lx >= 1024) return false;
        const int wgid = (int)xcd_remap(Lx, 1024), e = wgid >> 6, wl = wgid & 63, pmi = wl & 7, pni = ((wl >> 3) & 3) + 4 * (wl >> 5);
        u.pm = ((pmi >> 1) * 16 + e) * 2 + (pmi & 1); u.pn = e * 8 + pni; u.kind = 0; return true;
    }
    __device__ __forceinline__ void a_ready(const Unit&) const {}
    __device__ __forceinline__ void done(const Unit&) const {}
};
struct EpiGateUp {
    static constexpr bool PERM = true, AFTER_DRAIN = false;
    bf16_t* hbuf;
    __device__ __forceinline__ void operator()(const f32x4 (&acc)[2][2][4][2], const Unit& u, int wr, int wc, int fr, int fq) const {
        const int row0 = u.pm * BM + wr * 64 + fr, col0 = (u.pn & 7) * HALF + wc * 32 + 8 * fq;
#pragma unroll
        for (int ai = 0; ai < 2; ++ai)
#pragma unroll
            for (int m = 0; m < 4; ++m) { float h[8];
#pragma unroll
                for (int t = 0; t < 8; ++t) { const float g = acc[ai][0][m][t >> 2][t & 3], up = acc[ai][1][m][t >> 2][t & 3];
                    h[t] = g * __builtin_amdgcn_rcpf(1.0f + __builtin_amdgcn_exp2f(-1.4426950408889634f * g)) * up; }
                u32x4 w; w.x = pk2(h[0], h[1]); w.y = pk2(h[2], h[3]); w.z = pk2(h[4], h[5]); w.w = pk2(h[6], h[7]);
                *(u32x4*)(hbuf + (size_t)(row0 + ai * HALF + m * 16) * EH + col0) = w; }
    }
};
struct SchedP8 {
    int G, c;
    __device__ bool next(int i, Unit& u) const {
        const int Lx = i * G + c; if (Lx >= 512) return false;
        const int wgid = (int)xcd_remap(Lx, 512), e = wgid >> 5, wl = wgid & 31, pmi = wl & 7, pni = wl >> 3;
        u.pm = ((pmi >> 1) * 16 + e) * 2 + (pmi & 1); u.pn = e * 4 + pni; u.kind = 0; return true;
    }
    __device__ __forceinline__ void a_ready(const Unit&) const {}
    __device__ __forceinline__ void done(const Unit&) const {}
};
struct EpiDown {
    static constexpr bool PERM = false, AFTER_DRAIN = false;
    const int* seltok; const float* selgate; float* out;
    __device__ __forceinline__ void operator()(const f32x4 (&acc)[2][2][4][2], const Unit& u, int wr, int wc, int fr, int fq) const {
        const int g = u.pm >> 1, b = g >> 4, slot0 = (u.pm & 1) * BM + wr * 64 + fr, col0 = (u.pn & 3) * BM + wc * 32 + 4 * fq;
#pragma unroll
        for (int ai = 0; ai < 2; ++ai)
#pragma unroll
            for (int m = 0; m < 4; ++m) { const int slot = g * CAP + slot0 + ai * HALF + m * 16; const int tok = seltok[slot]; const float gt = selgate[slot];
                float* rowp = out + (size_t)(b * L + tok) * D + col0;
#pragma unroll
                for (int bj = 0; bj < 2; ++bj)
#pragma unroll
                    for (int n = 0; n < 2; ++n)
#pragma unroll
                        for (int e = 0; e < 4; ++e) atomicAdd(rowp + bj * HALF + n * 16 + e, gt * acc[ai][bj][m][n][e]); }
    }
};
}
namespace attn {
typedef short bf16x8 __attribute__((ext_vector_type(8)));
typedef short s16x4 __attribute__((ext_vector_type(4)));
typedef float f32x16 __attribute__((ext_vector_type(16)));
typedef unsigned u32x4 __attribute__((ext_vector_type(4)));
typedef float f32x2_t __attribute__((ext_vector_type(2))); typedef __bf16 bf16x2_t __attribute__((ext_vector_type(2)));
typedef __attribute__((address_space(3))) const char* lds_cptr;
typedef short v4i16_t __attribute__((ext_vector_type(4)));
constexpr int SLOT = 32768, NSLOT = 3, OFF_K1 = 0, OFF_K2 = 8192, OFF_V = 16384;
constexpr int OFF_X = 0, OFF_STG = 65536, OFF_WSF = 98304;
__device__ __forceinline__ int crow(int r, int hi) { return (r & 3) + 8 * (r >> 2) + 4 * hi; }
__device__ __forceinline__ void glds16(const void* gsrc, unsigned lds_dst) { unsigned keep;
    asm volatile("s_mov_b32 %0, m0\n\ts_mov_b32 m0, %2\n\ts_nop 0\n\tglobal_load_lds_dwordx4 %1, off\n\ts_mov_b32 m0, %0" : "=&s"(keep) : "v"(gsrc), "s"(lds_dst) : "memory"); }
__device__ __forceinline__ unsigned cvtpk(float lo, float hi) { f32x2_t v = {lo, hi}; bf16x2_t b = __builtin_convertvector(v, bf16x2_t); return __builtin_bit_cast(unsigned, b); }
__device__ __forceinline__ s16x4 vtr(lds_cptr p) { return __builtin_bit_cast(s16x4, __builtin_amdgcn_ds_read_tr16_b64_v4i16((__attribute__((address_space(3))) v4i16_t*)p)); }
#define ATT_WAIT_BAR(N) asm volatile("s_waitcnt vmcnt(" #N ") lgkmcnt(0)\n\ts_barrier" ::: "memory")

__device__ __forceinline__ void attn_unit(int b, int h, int qb, const bf16* qn, const bf16* kn, const bf16* vv, bf16* attn_out, const float* subln, float M2, float lam,
                                          __attribute__((address_space(3))) unsigned char* lds) {
    const int tid = threadIdx.x, lane = tid & 63, r32 = lane & 31, hi = lane >> 5; const int wid = __builtin_amdgcn_readfirstlane(tid >> 6);
    const int map = wid >> 2, qg = wid & 3;
    const unsigned lds0 = (unsigned)(uintptr_t)lds;
    const bf16* k1src = kn + (((size_t)b * 8 + h * 2 + 0) * L) * 64 + (size_t)lane * 64 + wid * 8;
    const bf16* k2src = kn + (((size_t)b * 8 + h * 2 + 1) * L) * 64 + (size_t)lane * 64 + wid * 8;
    const bf16* vbase = vv + (((size_t)b * NH + h) * L) * VD;
    const int pi0 = wid, pi1 = wid + 8;
    const bf16* v0src = vbase + (size_t)(16 * (pi0 & 3) + (lane >> 2)) * VD + (pi0 >> 2) * 32 + (lane & 3) * 8;
    const bf16* v1src = vbase + (size_t)(16 * (pi1 & 3) + (lane >> 2)) * VD + (pi1 >> 2) * 32 + (lane & 3) * 8;
#define ATT_DMA(t, slot) do { \
        glds16(k1src + (size_t)(t) * 64 * 64, (unsigned)__builtin_amdgcn_readfirstlane(lds0 + (slot) + OFF_K1 + wid * 1024)); \
        glds16(k2src + (size_t)(t) * 64 * 64, (unsigned)__builtin_amdgcn_readfirstlane(lds0 + (slot) + OFF_K2 + wid * 1024)); \
        glds16(v0src + (size_t)(t) * 64 * VD, (unsigned)__builtin_amdgcn_readfirstlane(lds0 + (slot) + OFF_V + pi0 * 1024)); \
        glds16(v1src + (size_t)(t) * 64 * VD, (unsigned)__builtin_amdgcn_readfirstlane(lds0 + (slot) + OFF_V + pi1 * 1024)); } while (0)
    constexpr int NT = L / 64;
    ATT_DMA(0, 0); ATT_DMA(1, SLOT);
    const int q0 = qb * 128 + qg * 32;
    const bf16* Qw = qn + (((size_t)b * 8 + h * 2 + map) * L + q0) * 64;
    bf16x8 qr[4];
#pragma unroll
    for (int d0 = 0; d0 < 4; ++d0) qr[d0] = *reinterpret_cast<const bf16x8*>(Qw + (size_t)r32 * 64 + d0 * 16 + hi * 8);
    f32x16 negm;
#pragma unroll
    for (int r = 0; r < 16; ++r) negm[r] = -M2;
    f32x16 o[4];
#pragma unroll
    for (int d = 0; d < 4; ++d) o[d] = f32x16{};
    float lsum = 0.f;
    const lds_cptr lds3 = (lds_cptr)lds;
    const lds_cptr kp0 = lds3 + (map ? OFF_K2 : OFF_K1) + hi * 1024 + r32 * 16;
    const lds_cptr vp0 = lds3 + OFF_V + ((lane >> 4) & 1) * 32 + (lane & 3) * 8 + (4 * hi + ((lane & 15) >> 2)) * 64;
    int sl_cur = 0, sl_nn = 2 * SLOT;
    for (int t = 0; t < NT; ++t) {
        if (t + 1 < NT) { ATT_WAIT_BAR(4); } else { ATT_WAIT_BAR(0); }
        if (t + 2 < NT) ATT_DMA(t + 2, sl_nn);
        const lds_cptr kp = kp0 + sl_cur, vp = vp0 + sl_cur;
        f32x16 p0, p1;
#pragma unroll
        for (int d0 = 0; d0 < 4; ++d0) {
            const bf16x8 b0 = *(const __attribute__((address_space(3))) bf16x8*)(kp + d0 * 2048);
            const bf16x8 b1 = *(const __attribute__((address_space(3))) bf16x8*)(kp + d0 * 2048 + 512);
            if (d0 == 0) { p0 = __builtin_amdgcn_mfma_f32_32x32x16_bf16(b0, qr[0], negm, 0, 0, 0); p1 = __builtin_amdgcn_mfma_f32_32x32x16_bf16(b1, qr[0], negm, 0, 0, 0); }
            else { p0 = __builtin_amdgcn_mfma_f32_32x32x16_bf16(b0, qr[d0], p0, 0, 0, 0); p1 = __builtin_amdgcn_mfma_f32_32x32x16_bf16(b1, qr[d0], p1, 0, 0, 0); }
        }
        float sa = 0.f, sb = 0.f;
#pragma unroll
        for (int r = 0; r < 16; ++r) { p0[r] = __builtin_amdgcn_exp2f(p0[r]); p1[r] = __builtin_amdgcn_exp2f(p1[r]); sa += p0[r]; sb += p1[r]; }
        lsum += sa + sb;
        u32x4 pw[4];
#pragma unroll
        for (int i = 0; i < 4; ++i) { pw[0][i] = cvtpk(p0[2 * i], p0[2 * i + 1]); pw[1][i] = cvtpk(p0[8 + 2 * i], p0[9 + 2 * i]); pw[2][i] = cvtpk(p1[2 * i], p1[2 * i + 1]); pw[3][i] = cvtpk(p1[8 + 2 * i], p1[9 + 2 * i]); }
#pragma unroll
        for (int db = 0; db < 4; ++db) {
#pragma unroll
            for (int ks = 0; ks < 4; ++ks) {
                const s16x4 lo = vtr(vp + db * 4096 + ks * 1024), hh = vtr(vp + db * 4096 + ks * 1024 + 512);
                const bf16x8 vf = (bf16x8){lo[0], lo[1], lo[2], lo[3], hh[0], hh[1], hh[2], hh[3]};
                o[db] = __builtin_amdgcn_mfma_f32_32x32x16_bf16(__builtin_bit_cast(bf16x8, pw[ks]), vf, o[db], 0, 0, 0);
            }
        }
        sl_cur = (sl_cur == (NSLOT - 1) * SLOT) ? 0 : sl_cur + SLOT;
        sl_nn = (sl_nn == (NSLOT - 1) * SLOT) ? 0 : sl_nn + SLOT;
    }
    { auto rr = __builtin_amdgcn_permlane32_swap(__float_as_uint(lsum), __float_as_uint(lsum), false, false); lsum = __uint_as_float(rr[0]) + __uint_as_float(rr[1]); }
    __attribute__((address_space(3))) float* wsf = (__attribute__((address_space(3))) float*)(lds + OFF_WSF) + wid * 64;
    asm volatile("s_waitcnt lgkmcnt(0)\n\ts_barrier" ::: "memory");
    if (hi == 0) wsf[r32] = lsum;
    asm volatile("s_waitcnt lgkmcnt(0)" ::: "memory");
    float rli[16];
#pragma unroll
    for (int r = 0; r < 16; ++r) rli[r] = __builtin_amdgcn_rcpf(wsf[crow(r, hi)]) * (map ? lam : 1.0f);
    __attribute__((address_space(3))) float* X = (__attribute__((address_space(3))) float*)(lds + OFF_X) + qg * 4096;
    if (map == 1) {
#pragma unroll
        for (int db = 0; db < 4; ++db)
#pragma unroll
            for (int r = 0; r < 16; ++r) X[crow(r, hi) * 128 + db * 32 + r32] = o[db][r] * rli[r];
    }
    asm volatile("s_waitcnt lgkmcnt(0)\n\ts_barrier" ::: "memory");
    if (map == 0) {
        float ss[16];
#pragma unroll
        for (int r = 0; r < 16; ++r) ss[r] = 0.f;
#pragma unroll
        for (int db = 0; db < 4; ++db)
#pragma unroll
            for (int r = 0; r < 16; ++r) { const float val = o[db][r] * rli[r] - X[crow(r, hi) * 128 + db * 32 + r32]; o[db][r] = val; ss[r] += val * val; }
#pragma unroll
        for (int r = 0; r < 16; ++r) { float s = ss[r]; s += __shfl_xor(s, 1); s += __shfl_xor(s, 2); s += __shfl_xor(s, 4); s += __shfl_xor(s, 8); s += __shfl_xor(s, 16);
            ss[r] = (1.0f - LAMBDA_INIT) / sqrtf(s * (1.0f / 128) + EPS); }
        __attribute__((address_space(3))) bf16* stg = (__attribute__((address_space(3))) bf16*)(lds + OFF_STG) + qg * 4096;
#pragma unroll
        for (int db = 0; db < 4; ++db) { const float gg = subln[db * 32 + r32];
#pragma unroll
            for (int r = 0; r < 16; ++r) stg[crow(r, hi) * 128 + db * 32 + r32] = (bf16)f2bf(o[db][r] * ss[r] * gg); }
        asm volatile("s_waitcnt lgkmcnt(0)" ::: "memory");
        bf16* Ow = attn_out + ((size_t)b * L + q0) * AW + h * VD;
#pragma unroll
        for (int i = 0; i < 8; ++i) { const int row = i * 4 + (lane >> 4), ch = lane & 15;
            const u32x4 val = *(const __attribute__((address_space(3))) u32x4*)(stg + row * 128 + ch * 8);
            *(u32x4*)(Ow + (size_t)row * AW + ch * 8) = val; }
    }
    asm volatile("s_waitcnt lgkmcnt(0)\n\ts_barrier" ::: "memory");
#undef ATT_DMA
}
#undef ATT_WAIT_BAR
}
namespace hy {
typedef float f32x2 __attribute__((ext_vector_type(2)));
typedef float f32x4v __attribute__((ext_vector_type(4)));
#define HLAS __attribute__((address_space(3)))
constexpr int N = 8192, OFF_BUF = 0, OFF_H1 = 69632, OFF_H2 = 69632 + 32832, HY_LDS_END = 69632 + 2 * 32832;
__device__ __forceinline__ int phys(int i) { return i + (i >> 4); }
__device__ __forceinline__ int opq(int x) { asm volatile("" : "+v"(x)); return x; }
__device__ __forceinline__ f32x2 cmul(f32x2 a, f32x2 b) { return (f32x2){a.x * b.x - a.y * b.y, a.x * b.y + a.y * b.x}; }
__device__ __forceinline__ f32x2 cmulc(f32x2 a, f32x2 b) { return (f32x2){a.x * b.x + a.y * b.y, a.y * b.x - a.x * b.y}; }
__device__ __forceinline__ f32x2 twid(float frac) { return (f32x2){__builtin_amdgcn_cosf(frac), __builtin_amdgcn_sinf(frac)}; }
__device__ __forceinline__ f32x2 mul_mi(f32x2 a) { return (f32x2){a.y, -a.x}; }
#define HY_FFT4(a0, a1, a2, a3, r0, r1, r2, r3) do { const f32x2 t0_ = a0 + a2, t1_ = a0 - a2, t2_ = a1 + a3, t3_ = mul_mi(a1 - a3); r0 = t0_ + t2_; r1 = t1_ + t3_; r2 = t0_ - t2_; r3 = t1_ - t3_; } while (0)
__device__ __forceinline__ void fft16(const f32x2 (&u)[16], f32x2 (&v)[16]) {
    constexpr float C1 = 0.92387953251128674f, S1 = 0.38268343236508977f, R2 = 0.70710678118654752f;
    f32x2 y[16];
#pragma unroll
    for (int n1 = 0; n1 < 4; ++n1) HY_FFT4(u[n1], u[n1 + 4], u[n1 + 8], u[n1 + 12], y[n1], y[n1 + 4], y[n1 + 8], y[n1 + 12]);
    y[5] = cmul(y[5], (f32x2){C1, -S1});  y[9] = cmul(y[9], (f32x2){R2, -R2});   y[13] = cmul(y[13], (f32x2){S1, -C1});
    y[6] = cmul(y[6], (f32x2){R2, -R2});  y[10] = mul_mi(y[10]);                 y[14] = cmul(y[14], (f32x2){-R2, -R2});
    y[7] = cmul(y[7], (f32x2){S1, -C1});  y[11] = cmul(y[11], (f32x2){-R2, -R2}); y[15] = cmul(y[15], (f32x2){-C1, S1});
#pragma unroll
    for (int k2 = 0; k2 < 4; ++k2) HY_FFT4(y[4 * k2], y[4 * k2 + 1], y[4 * k2 + 2], y[4 * k2 + 3], v[k2], v[4 + k2], v[8 + k2], v[12 + k2]);
}
__device__ __forceinline__ void load16(const HLAS f32x2* buf, int tid, f32x2 (&u)[16]) {
    const HLAS f32x2* b = buf + phys(tid);
#pragma unroll
    for (int r = 0; r < 16; ++r) u[r] = b[544 * r];
}
template <int PS> __device__ __forceinline__ void store16(HLAS f32x2* buf, int j, const f32x2 (&v)[16]) {
    HLAS f32x2* b = buf + phys(j);
#pragma unroll
    for (int r = 0; r < 16; ++r) b[PS * r] = v[r];
}
__device__ __forceinline__ void twiddle16(f32x2 (&u)[16], int k, float inv_pr) {
    const f32x2 w1 = twid(-(float)k * inv_pr); f32x2 w = w1;
#pragma unroll
    for (int r = 1; r < 16; ++r) { u[r] = cmul(u[r], w); w = cmul(w, w1); }
}
__device__ __forceinline__ void passes_bc(HLAS f32x2* buf, int tid_) {
    f32x2 u[16], v[16];
    int tid = opq(tid_);
    load16(buf, tid, u); __syncthreads();
    { const int k = tid & 15; twiddle16(u, k, 1.0f / 256.0f); fft16(u, v); store16<17>(buf, (tid - k) * 16 + k, v); }
    __syncthreads();
    tid = opq(tid_);
    load16(buf, tid, u); __syncthreads();
    { const int k = tid & 255; twiddle16(u, k, 1.0f / 4096.0f); fft16(u, v); store16<272>(buf, (tid - k) * 16 + k, v); }
    __syncthreads();
}
__device__ __forceinline__ void fft_lds(HLAS f32x2* buf, int tid_) {
    int tid = opq(tid_);
    { f32x2 u[16], v[16]; load16(buf, tid, u); __syncthreads(); fft16(u, v); store16<1>(buf, tid * 16, v); }
    __syncthreads();
    passes_bc(buf, tid_);
    tid = opq(tid_);
    { HLAS f32x2* b = buf + phys(tid);
#pragma unroll
    for (int q = 0; q < 8; ++q) { const int ii = tid + 512 * q; const f32x2 a = b[544 * q], c = cmul(b[544 * (q + 8)], twid(-(float)ii * (1.0f / 8192.0f)));
        b[544 * q] = a + c; b[544 * (q + 8)] = a - c; } }
    __syncthreads();
}
__device__ __forceinline__ void conv_apply(HLAS f32x2* buf, const HLAS f32x2* Hh, int tid, const float (&zr)[8], const float (&zi)[8], float (&yr)[8], float (&yi)[8]) {
    const int tid_ = tid;
    __syncthreads();
    tid = opq(tid_);
    { f32x2 u[16], v[16];
#pragma unroll
      for (int r = 0; r < 8; ++r) { u[r] = (f32x2){zr[r], zi[r]}; u[r + 8] = (f32x2){0.f, 0.f}; }
      fft16(u, v); store16<1>(buf, tid * 16, v); }
    __syncthreads();
    passes_bc(buf, tid_);
    tid = opq(tid_);
    { HLAS f32x2* b = buf + phys(tid); const HLAS f32x2* ha = Hh + tid; const HLAS f32x2* hb = Hh + (4096 - 512 * 7) - tid;
#pragma unroll
    for (int q = 0; q < 8; ++q) { const int ii = tid + 512 * q; const f32x2 a = b[544 * q], c = cmul(b[544 * (q + 8)], twid(-(float)ii * (1.0f / 8192.0f)));
        const f32x2 d0 = a + c, d1 = a - c, h0 = ha[512 * q], h1 = hb[512 * (7 - q)];
        const f32x2 y0 = cmul(d0, h0), y1 = cmulc(d1, h1);
        b[544 * q] = (f32x2){y0.x, -y0.y}; b[544 * (q + 8)] = (f32x2){y1.x, -y1.y}; } }
    __syncthreads();
    tid = opq(tid_);
    { f32x2 u[16], v[16]; load16(buf, tid, u); __syncthreads(); fft16(u, v); store16<1>(buf, tid * 16, v); }
    __syncthreads();
    passes_bc(buf, tid_);
    tid = opq(tid_);
    { const HLAS f32x2* b = buf + phys(tid);
#pragma unroll
    for (int q = 0; q < 8; ++q) { const int ii = tid + 512 * q; const f32x2 a = b[544 * q], c = cmul(b[544 * (q + 8)], twid(-(float)ii * (1.0f / 8192.0f)));
        const f32x2 r = a + c; yr[q] = r.x; yi[q] = -r.y; } }
}
__device__ __forceinline__ float sconv(const bf16* h, int l, float w0, float w1, float w2, float bias) {
    float v = bf2f(h[l]) * w1 + bias;
    if (l > 0) v += bf2f(h[l - 1]) * w0;
    if (l < L - 1) v += bf2f(h[l + 1]) * w2;
    return v;
}
__device__ __forceinline__ void hyena_channel(const P& p, int c, HLAS unsigned char* lds, int tid_) {
    int tid = opq(tid_);
    HLAS f32x2* buf = (HLAS f32x2*)(lds + OFF_BUF); HLAS f32x2* H1 = (HLAS f32x2*)(lds + OFF_H1); HLAS f32x2* H2 = (HLAS f32x2*)(lds + OFF_H2);
    const float* hid3 = (const float*)(p.ws + WS_HID3);
    const bf16* hyT = (const bf16*)(p.ws + WS_HYT); bf16* hyo = (bf16*)(p.ws + WS_HYENA);
    __syncthreads();
    {
        float f[8][4];
#pragma unroll
        for (int q = 0; q < 8; ++q)
#pragma unroll
            for (int od = 0; od < 4; ++od) f[q][od] = 0.f;
#pragma unroll 1
        for (int jc = 0; jc < 16; ++jc) {
            float wv[4][4];
#pragma unroll
            for (int jj = 0; jj < 4; ++jj)
#pragma unroll
                for (int od = 0; od < 4; ++od) wv[jj][od] = p.fwo[(size_t)(4 * jc + jj) * 2048 + od * 512 + c];
#pragma unroll
            for (int q = 0; q < 8; ++q) { const f32x4v h = *(const f32x4v*)(hid3 + (size_t)(tid + 512 * q) * 64 + 4 * jc);
#pragma unroll
                for (int od = 0; od < 4; ++od) f[q][od] += h[0] * wv[0][od] + h[1] * wv[1][od] + h[2] * wv[2][od] + h[3] * wv[3][od]; }
        }
        const float mind = logf(1e-2f) / 1.5f, maxd = logf(1e-2f) / 0.3f;
        const float delta = fabsf(mind + (maxd - mind) * (float)c / 511.0f);
#pragma unroll
        for (int q = 0; q < 8; ++q) { const int l = tid + 512 * q; const float dec = expf(-((float)l / (float)(L - 1)) * delta);
            buf[phys(l)] = (f32x2){f[q][0] * dec, f[q][2] * dec};
            if (l >= 1) buf[phys(N - l)] = (f32x2){f[q][1] * dec, f[q][3] * dec}; }
        if (tid == 0) buf[phys(4096)] = (f32x2){0.f, 0.f};
    }
    __syncthreads();
    fft_lds(buf, tid_);
    tid = opq(tid_);
#pragma unroll
    for (int q = 0; q < 8; ++q) { const int k = tid + 512 * q; const f32x2 wk = buf[phys(k)], wn = buf[phys((N - k) & (N - 1))];
        const float s = 0.5f / (float)N;
        H1[k] = (f32x2){(wk.x + wn.x) * s, (wk.y - wn.y) * s};
        H2[k] = (f32x2){(wk.y + wn.y) * s, (wn.x - wk.x) * s}; }
    if (tid == 0) { const f32x2 wk = buf[phys(4096)]; H1[4096] = (f32x2){wk.x / (float)N, 0.f}; H2[4096] = (f32x2){wk.y / (float)N, 0.f}; }
    const float w0z = p.scw[c], w1z = p.scw[HYC + c], w2z = p.scw[2 * HYC + c], bz = p.scb[c];
    const float w0a = p.scw[512 + c], w1a = p.scw[HYC + 512 + c], w2a = p.scw[2 * HYC + 512 + c], ba = p.scb[512 + c];
    const float w0b = p.scw[1024 + c], w1b = p.scw[HYC + 1024 + c], w2b = p.scw[2 * HYC + 1024 + c], bb = p.scb[1024 + c];
    const float sk1 = p.hskip[c], sk2 = p.hskip[512 + c];
#pragma unroll 1
    for (int pp = 0; pp < 2; ++pp) {
        const int b0 = 2 * pp, b1 = 2 * pp + 1;
        const bf16* z0p = hyT + ((size_t)b0 * HYC + c) * L; const bf16* z1p = hyT + ((size_t)b1 * HYC + c) * L;
        float zr[8], zi[8], yr[8], yi[8];
        tid = opq(tid_);
#pragma unroll
        for (int q = 0; q < 8; ++q) { const int l = tid + 512 * q; zr[q] = sconv(z0p, l, w0z, w1z, w2z, bz); zi[q] = sconv(z1p, l, w0z, w1z, w2z, bz); }
        conv_apply(buf, H1, tid_, zr, zi, yr, yi);
        tid = opq(tid_);
#pragma unroll
        for (int q = 0; q < 8; ++q) { const int l = tid + 512 * q;
            zr[q] = sconv(z0p + (size_t)512 * L, l, w0a, w1a, w2a, ba) * (yr[q] + sk1 * zr[q]);
            zi[q] = sconv(z1p + (size_t)512 * L, l, w0a, w1a, w2a, ba) * (yi[q] + sk1 * zi[q]); }
        conv_apply(buf, H2, tid_, zr, zi, yr, yi);
        tid = opq(tid_);
#pragma unroll
        for (int q = 0; q < 8; ++q) { const int l = tid + 512 * q;
            const float o0 = sconv(z0p + (size_t)1024 * L, l, w0b, w1b, w2b, bb) * (yr[q] + sk2 * zr[q]);
            const float o1 = sconv(z1p + (size_t)1024 * L, l, w0b, w1b, w2b, bb) * (yi[q] + sk2 * zi[q]);
            hyo[((size_t)b0 * L + l) * HW + c] = (bf16)f2bf(o0); hyo[((size_t)b1 * L + l) * HW + c] = (bf16)f2bf(o1); }
    }
    __syncthreads();
}
#undef HLAS
}
#define LAS __attribute__((address_space(3)))
constexpr int NWAVES = 8, NTHR = 512;
constexpr int RING_BYTES = 131072, LDS_BYTES = 147456;
#define LDS_WAIT() asm volatile("s_waitcnt lgkmcnt(0)" ::: "memory")

__device__ __forceinline__ int colmap_in(int R) {
    if (R >= 3584) return 1536 + (R - 3584);
    const int pn = R >> 8, rt = R & 255;
    if (pn < 4) { const int bj = rt >> 7, wc = (rt >> 5) & 3, i = rt & 31, gidx = pn * 4 + wc;
        const int d = (bj == 0 && i < 16) ? (4 * (i >> 3) + ((i & 7) >> 1) + 8 * (i & 1)) : (32 * bj + i);
        return gidx * 64 + d; }
    if (pn < 6) return 1024 + (pn - 4) * 256 + rt;
    return 3072 + (pn - 6) * 256 + rt;
}
__device__ __forceinline__ void transpose_item(const float* W, int N, int K, bf16* WT, int k0, int drow0, int scol, const float* kscale, LAS float* scr, int lane) {
#pragma unroll 8
    for (int i = 0; i < 32; ++i) { const int kk = 2 * i + (lane >> 5); float v = W[(size_t)(k0 + kk) * N + scol]; if (kscale) v *= kscale[k0 + kk]; scr[kk * 33 + (lane & 31)] = v; }
    LDS_WAIT(); asm volatile("" ::: "memory");
    const int c = lane & 7;
#pragma unroll
    for (int j = 0; j < 4; ++j) { const int n = (lane >> 3) + 8 * j; const LAS float* s = scr + (8 * c) * 33 + n;
        uint4 o; o.x = pk2(s[0 * 33], s[1 * 33]); o.y = pk2(s[2 * 33], s[3 * 33]); o.z = pk2(s[4 * 33], s[5 * 33]); o.w = pk2(s[6 * 33], s[7 * 33]);
        *(uint4*)(WT + (size_t)(drow0 + n) * K + k0 + 8 * c) = o; }
    LDS_WAIT(); asm volatile("" ::: "memory");
}
__device__ __forceinline__ void p0_prologue(const P& p, LAS unsigned char* lds, int gw, int NGW, int wave, int lane, int gt, int NGT) {
    LAS float* scr = (LAS float*)(lds + wave * 16384);
    unsigned char* ws = p.ws;
    constexpr int I_IN = 16 * 160, I_PA = 8 * 32, I_O = 16 * 32, NITEMS = I_IN + 2 * I_PA + I_O;
    for (int it = gw; it < NITEMS; it += NGW) {
        int r = it;
        if (r < I_IN) { const int kb = r / 160, nb = r % 160; transpose_item(p.w_in, INC, D, (bf16*)(ws + WS_WINT), kb * 64, nb * 32, colmap_in(nb * 32 + (lane & 31)), p.norm1_g, scr, lane); continue; } r -= I_IN;
        if (r < I_PA) { const int kb = r / 32, nb = r % 32; transpose_item(p.wpa, D, 512, (bf16*)(ws + WS_WPA), kb * 64, nb * 32, nb * 32 + (lane & 31), nullptr, scr, lane); continue; } r -= I_PA;
        if (r < I_PA) { const int kb = r / 32, nb = r % 32; transpose_item(p.wph, D, 512, (bf16*)(ws + WS_WPH), kb * 64, nb * 32, nb * 32 + (lane & 31), nullptr, scr, lane); continue; } r -= I_PA;
        { const int kb = r / 32, nb = r % 32; transpose_item(p.wo, D, D, (bf16*)(ws + WS_WO), kb * 64, nb * 32, nb * 32 + (lane & 31), nullptr, scr, lane); }
    }
    float* rstd1 = (float*)(ws + WS_RSTD1); bf16* xb = (bf16*)(ws + WS_XB);
    for (int t = gw; t < T; t += NGW) {
        const float4* xr = (const float4*)(p.x + (size_t)t * D);
        float s = 0.f;
#pragma unroll
        for (int j = 0; j < 4; ++j) { const float4 v = xr[lane + 64 * j]; s += v.x * v.x + v.y * v.y + v.z * v.z + v.w * v.w;
            uint2 pk; pk.x = pk2(v.x, v.y); pk.y = pk2(v.z, v.w); ((uint2*)(xb + (size_t)t * D))[lane + 64 * j] = pk; }
        s = wave_sum(s);
        if (lane == 0) rstd1[t] = 1.0f / sqrtf(s * (1.0f / D) + EPS);
    }
    float* rc = (float*)(ws + WS_ROPE); float* rs = rc + L * 8;
    for (int i = gt; i < L * 8; i += NGT) {
        const int l = i >> 3, j = i & 7;
        const double ang = (double)l * pow(500000.0, -(double)j / 8.0);
        rc[i] = (float)cos(ang); rs[i] = (float)sin(ang);
    }
    float* hid3 = (float*)(ws + WS_HID3);
    for (int l = gw; l < L; l += NGW) {
        const float t = (float)l / (float)(L - 1);
        const float fr = p.ffreq[lane];
        float a = p.fb1[lane] + t * p.fw1[lane];
        for (int j = 0; j < 16; ++j) {
            const float band = 1e-4f + (float)j * ((15.0f - 1e-4f) / 15.0f);
            const float ang = (2.0f * 3.14159265358979323846f / (float)L) * (float)l * band;
            a += cosf(ang) * p.fw1[(1 + j) * 64 + lane] - sinf(ang) * p.fw1[(17 + j) * 64 + lane];
        }
        float h = sinf(fr * a);
        float a2 = p.fb2[lane];
        for (int i = 0; i < 64; ++i) a2 += __shfl(h, i) * p.fw2[i * 64 + lane];
        h = sinf(fr * a2);
        float a3 = p.fb3[lane];
        for (int i = 0; i < 64; ++i) a3 += __shfl(h, i) * p.fw3[i * 64 + lane];
        hid3[l * 64 + lane] = sinf(fr * a3);
    }
}

__device__ __forceinline__ void p5_router(const P& p, LAS unsigned char* lds, int gw, int NGW, int tid, int lane) {
    LAS float* wrT = (LAS float*)lds;
    for (int i = tid; i < D * NE; i += NTHR) { const int d = i >> 4, e = i & 15; wrT[e * D + d] = p.wr[i]; }
    __syncthreads();
    float* aff = (float*)(p.ws + WS_AFF); bf16* u2 = (bf16*)(p.ws + WS_U2);
    for (int t = gw; t < T; t += NGW) {
        const float4* xr = (const float4*)(p.out + (size_t)t * D);
        float4 u[4]; float s = 0.f;
#pragma unroll
        for (int j = 0; j < 4; ++j) { u[j] = xr[lane + 64 * j]; s += u[j].x * u[j].x + u[j].y * u[j].y + u[j].z * u[j].z + u[j].w * u[j].w; }
        const float r = 1.0f / sqrtf(wave_sum(s) * (1.0f / D) + EPS);
#pragma unroll
        for (int j = 0; j < 4; ++j) {
            const float4 g = ((const float4*)p.norm2_g)[lane + 64 * j];
            u[j].x *= r * g.x; u[j].y *= r * g.y; u[j].z *= r * g.z; u[j].w *= r * g.w;
            uint2 pk; pk.x = pk2(u[j].x, u[j].y); pk.y = pk2(u[j].z, u[j].w);
            ((uint2*)(u2 + (size_t)t * D))[lane + 64 * j] = pk;
        }
        float mine = 0.f, mx = -1e30f;
#pragma unroll
        for (int e = 0; e < NE; ++e) {
            float a = 0.f;
#pragma unroll
            for (int j = 0; j < 4; ++j) { const pg8::f32x4 w = ((const LAS pg8::f32x4*)(wrT + e * D))[lane + 64 * j]; a += u[j].x * w[0] + u[j].y * w[1] + u[j].z * w[2] + u[j].w * w[3]; }
            a = wave_sum(a);
            mx = fmaxf(mx, a);
            if (lane == e) mine = a;
            asm volatile("" ::: "memory");
        }
        const float ex = (lane < NE) ? expf(mine - mx) : 0.f;
        const float se = wave_sum(ex);
        const int b = t / L, l = t % L;
        if (lane < NE) aff[((size_t)b * NE + lane) * L + l] = ex / se;
    }
    __syncthreads();
}

__device__ __forceinline__ void p6_topk_group(const P& p, LAS unsigned char* lds, int g, int tid, int lane, int wid) {
    LAS unsigned* cnt = (LAS unsigned*)lds; LAS unsigned* wsum = cnt + 8;
    const float* aff = (const float*)(p.ws + WS_AFF) + (size_t)g * L;
    unsigned v[8];
#pragma unroll
    for (int i = 0; i < 8; ++i) v[i] = __builtin_bit_cast(unsigned, aff[tid * 8 + i]);
    unsigned prefix = 0;
    for (int bit = 31; bit >= 0; --bit) {
        const unsigned cand = prefix | (1u << bit);
        unsigned c = 0;
#pragma unroll
        for (int i = 0; i < 8; ++i) c += (v[i] >= cand) ? 1u : 0u;
        c = (unsigned)wave_sum((float)c);
        if (lane == 0) cnt[wid] = c;
        __syncthreads();
        unsigned tot = 0;
#pragma unroll
        for (int w = 0; w < 8; ++w) tot += cnt[w];
        __syncthreads();
        if (tot >= CAP) prefix = cand;
    }
    unsigned ngt = 0, neq = 0;
#pragma unroll
    for (int i = 0; i < 8; ++i) { ngt += v[i] > prefix; neq += v[i] == prefix; }
    unsigned sg = ngt, se = neq;
#pragma unroll
    for (int o = 1; o < 64; o <<= 1) { const unsigned a = __shfl_up(sg, o), c = __shfl_up(se, o); if (lane >= o) { sg += a; se += c; } }
    if (lane == 63) { cnt[wid] = sg; wsum[wid] = se; }
    __syncthreads();
    unsigned og = 0, oe = 0, totg = 0;
#pragma unroll
    for (int w = 0; w < 8; ++w) { if (w < wid) { og += cnt[w]; oe += wsum[w]; } totg += cnt[w]; }
    unsigned pg = og + sg - ngt, pe = oe + se - neq;
    const unsigned need_eq = CAP - totg;
    int* stok = (int*)(p.ws + WS_SELTOK) + g * CAP; float* sgate = (float*)(p.ws + WS_SELGATE) + g * CAP;
    LAS int* ltok = (LAS int*)(lds + 256);
#pragma unroll
    for (int i = 0; i < 8; ++i) {
        if (v[i] > prefix) { stok[pg] = tid * 8 + i; ltok[pg] = tid * 8 + i; sgate[pg] = __builtin_bit_cast(float, v[i]); ++pg; }
        else if (v[i] == prefix) { if (pe < need_eq) { stok[totg + pe] = tid * 8 + i; ltok[totg + pe] = tid * 8 + i; sgate[totg + pe] = __builtin_bit_cast(float, v[i]); } ++pe; }
    }
    __syncthreads();
    const bf16* u2 = (const bf16*)(p.ws + WS_U2) + (size_t)(g >> 4) * L * D; bf16* xin = (bf16*)(p.ws + WS_XIN) + (size_t)g * CAP * D;
    for (int s0 = wid * 64; s0 < wid * 64 + 64; s0 += 8) {
        pg8::u32x4 r0[8], r1[8];
#pragma unroll
        for (int i = 0; i < 8; ++i) { const pg8::u32x4* src = (const pg8::u32x4*)(u2 + (size_t)ltok[s0 + i] * D); r0[i] = src[lane]; r1[i] = src[lane + 64]; }
#pragma unroll
        for (int i = 0; i < 8; ++i) { pg8::u32x4* dst = (pg8::u32x4*)(xin + (size_t)(s0 + i) * D); dst[lane] = r0[i]; dst[lane + 64] = r1[i]; }
    }
    __syncthreads();
}
__device__ __forceinline__ void p6_convert_experts(const P& p, LAS unsigned char* lds, int gw, int NGW, int wave, int lane) {
    LAS float* scr = (LAS float*)(lds + 16384 + wave * 12288);
    constexpr int PER_E = 16 * 64 + 16 * 32;
    for (int it = gw; it < NE * PER_E; it += NGW) {
        const int e = it / PER_E; int r = it % PER_E;
        if (r < 1024) { const int kb = r >> 6, nb = r & 63, rho = nb * 32, bj = (rho >> 7) & 1, f0 = (rho >> 8) * 128 + (rho & 127);
            transpose_item((bj ? p.wu : p.wg) + (size_t)e * D * EH, EH, D, (bf16*)(p.ws + WS_WGU) + (size_t)e * 2048 * D, kb * 64, rho, f0 + (lane & 31), nullptr, scr, lane); }
        else { r -= 1024; const int kb = r >> 5, nb = r & 31;
            transpose_item(p.wd + (size_t)e * EH * D, D, EH, (bf16*)(p.ws + WS_WD) + (size_t)e * D * EH, kb * 64, nb * 32, nb * 32 + (lane & 31), nullptr, scr, lane); }
    }
}

__global__ void __launch_bounds__(NTHR, 2) mega(P p) {
    extern __shared__ __attribute__((aligned(16))) unsigned char lds_raw[];
    LAS unsigned char* lds = (LAS unsigned char*)lds_raw;
    const int tid = threadIdx.x, lane = tid & 63, wave = __builtin_amdgcn_readfirstlane(tid >> 6);
    const int G = gridDim.x, bx = blockIdx.x;
    const int vcu = (G % 8 == 0) ? (bx % 8) * (G / 8) + bx / 8 : bx;
    const int gw = vcu * NWAVES + wave, NGW = G * NWAVES, gt = bx * NTHR + tid, NGT = G * NTHR;
    unsigned char* ws = p.ws;
#define IN(k) (p.ph_lo <= (k) && (k) < p.ph_hi)
#define SEAM(k) do { if (IN(k) && IN((k) + 1)) { cooperative_groups::this_grid().sync(); } } while (0)
    if (IN(0)) p0_prologue(p, lds, gw, NGW, wave, lane, gt, NGT);
    SEAM(0);
    if (IN(1)) {
        pg8::Gemm g{(const bf16*)(ws + WS_XB), (const bf16*)(ws + WS_WINT), (const bf16*)(ws + WS_WINT) + (size_t)3584 * D, (const bf16*)(ws + WS_XB), D};
        pg8::SchedP1 S{G, bx};
        pg8::EpiInProj E{(const float*)(ws + WS_RSTD1), (const float*)(ws + WS_ROPE), p.qng, p.kng, (bf16*)(ws + WS_QN), (bf16*)(ws + WS_KN), (bf16*)(ws + WS_V), (bf16*)(ws + WS_HYT), (bf16*)(ws + WS_GATES)};
        pg8::gemm_phase<pg8::EpiInProj, pg8::SchedP1, true, true>(lds, g, S, E);
    }
    SEAM(1);
    if (IN(2)) {
        const float M2 = static_max_log2(p), lam = calc_lam(p);
        for (int uid = vcu; uid < 512; uid += G) { const int bh = uid >> 5, qb = uid & 31;
            attn::attn_unit(bh >> 2, bh & 3, qb, (const bf16*)(ws + WS_QN), (const bf16*)(ws + WS_KN), (const bf16*)(ws + WS_V), (bf16*)(ws + WS_ATTN), p.subln, M2, lam, lds); }
#if FAST_LEVEL >= 5
#pragma unroll 1
        for (int c = vcu; c < HW; c += G) hy::hyena_channel(p, c, lds, tid);
#endif
    }
    SEAM(2);
    if (IN(3)) {
        pg8::Gemm g{(const bf16*)(ws + WS_ATTN), (const bf16*)(ws + WS_WPA), (const bf16*)(ws + WS_HYENA), (const bf16*)(ws + WS_WPH), 512};
        pg8::SchedP3 S; S.so.init(T, D, G, bx);
        pg8::EpiMerge E{(const bf16*)(ws + WS_GATES), (bf16*)(ws + WS_TMPM), (bf16*)(ws + WS_MERGED)};
        pg8::gemm_phase<pg8::EpiMerge, pg8::SchedP3, true, true>(lds, g, S, E);
    }
    SEAM(3);
    if (IN(4)) {
        pg8::Gemm g{(const bf16*)(ws + WS_MERGED), (const bf16*)(ws + WS_WO), nullptr, nullptr, D};
        pg8::StaticOrder S; S.init(T, D, G, bx);
        pg8::EpiOutProj E{p.x, p.out};
        pg8::gemm_phase<pg8::EpiOutProj, pg8::StaticOrder, true, true>(lds, g, S, E);
    }
    SEAM(4);
    if (IN(5)) p5_router(p, lds, gw, NGW, tid, lane);
    SEAM(5);
    if (IN(6)) {
        if (bx < 64) p6_topk_group(p, lds, bx, tid, lane, wave);
        p6_convert_experts(p, lds, gw, NGW, wave, lane);
    }
    SEAM(6);
    if (IN(7)) {
        pg8::Gemm g{(const bf16*)(ws + WS_XIN), (const bf16*)(ws + WS_WGU), nullptr, nullptr, D};
        pg8::SchedP7 S{G, bx};
        pg8::EpiGateUp E{(bf16*)(ws + WS_HBUF)};
        pg8::gemm_phase<pg8::EpiGateUp, pg8::SchedP7, true, true>(lds, g, S, E);
    }
    SEAM(7);
    if (IN(8)) {
        pg8::Gemm g{(const bf16*)(ws + WS_HBUF), (const bf16*)(ws + WS_WD), nullptr, nullptr, EH};
        pg8::SchedP8 S{G, bx};
        pg8::EpiDown E{(const int*)(ws + WS_SELTOK), (const float*)(ws + WS_SELGATE), p.out};
        pg8::gemm_phase<pg8::EpiDown, pg8::SchedP8, true, true>(lds, g, S, E);
    }
#undef IN
}

extern "C" void kernel_launch(void* const* d_in, const int* in_sizes, int n_in, void* d_out, int out_size, void* d_ws, size_t ws_size, hipStream_t stream) {
    static int ok = 0;
    if (ok == 0) {
        if (n_in != 29 || ws_size < WS_END) { fprintf(stderr, "kernel_launch: bad args n_in=%d ws=%zu\n", n_in, ws_size); ok = -1; return; }
        if (hipFuncSetAttribute((const void*)mega, hipFuncAttributeMaxDynamicSharedMemorySize, LDS_BYTES) != hipSuccess) { fprintf(stderr, "hipFuncSetAttribute failed\n"); ok = -1; return; }
        ok = 1;
    }
    if (ok < 0) return;
    P p{};
    const float** f = (const float**)&p;
    for (int i = 0; i < 29; ++i) f[i] = (const float*)d_in[i];
    p.out = (float*)d_out; p.ws = (unsigned char*)d_ws;
    (void)hipMemsetAsync((char*)d_ws + WS_CTL, 0, 1 * MiB, stream);
#if ONE_LAUNCH
    p.ph_lo = 0; p.ph_hi = 9;
    { void* args[] = {&p}; hipError_t e = hipLaunchCooperativeKernel((const void*)mega, dim3(256), dim3(NTHR), args, LDS_BYTES, stream);
      if (e != hipSuccess) fprintf(stderr, "cooperative launch failed: %s\n", hipGetErrorString(e)); }
#else
#define MEGA(lo, hi) do { p.ph_lo = (lo); p.ph_hi = (hi); hipLaunchKernelGGL(mega, dim3(256), dim3(NTHR), LDS_BYTES, stream, p); } while (0)
    MEGA(0, 1); MEGA(1, 2); MEGA(2, 3); MEGA(3, 4); MEGA(4, 5); MEGA(5, 6); MEGA(6, 7); MEGA(7, 8); MEGA(8, 9);
#endif
}
```

```cpp
#include <hip/hip_runtime.h>
#include <hip/hip_cooperative_groups.h>
#include <cstdio>
#include <cstdint>
#include <cmath>

#ifndef ONE_LAUNCH
#define ONE_LAUNCH 1
#endif
#ifndef CG_SEAM
#define CG_SEAM 0
#endif
#ifndef USE_XCD_BAR
#define USE_XCD_BAR 1
#endif
#ifndef PROBE_ATT
#define PROBE_ATT 1
#endif
#ifndef PROBE_HY
#define PROBE_HY 1
#endif
#ifndef PROBE_P0
#define PROBE_P0 1
#endif
#ifndef PROBE_P1
#define PROBE_P1 1
#endif
#ifndef PROBE_P3
#define PROBE_P3 1
#endif
#ifndef PROBE_P4
#define PROBE_P4 1
#endif
#ifndef PROBE_P5
#define PROBE_P5 1
#endif
#ifndef PROBE_P6
#define PROBE_P6 1
#endif
#ifndef PROBE_P7
#define PROBE_P7 1
#endif
#ifndef PROBE_SUB
#define PROBE_SUB 0
#endif
#ifndef PROBE_DBL
#define PROBE_DBL -1
#endif
#ifndef REP_EpiInProj
#define REP_EpiInProj 1
#endif
#ifndef REP_EpiMerge
#define REP_EpiMerge 1
#endif
#ifndef REP_EpiOutProj
#define REP_EpiOutProj 1
#endif
#ifndef REP_EpiGateUp
#define REP_EpiGateUp 1
#endif
#ifndef REP_EpiDown
#define REP_EpiDown 1
#endif
#ifndef FAST_LEVEL
#define FAST_LEVEL 5
#endif
constexpr int Bn = 4, L = 4096, D = 1024, T = Bn * L;
constexpr int NH = 4, QK = 64, VD = 128, AW = 512;
constexpr int HW = 512, HYC = 1536, GC = 2048, INC = 5120;
constexpr int NE = 16, CAP = 512, EH = 1024;
constexpr float EPS = 1e-6f;
constexpr float LAMBDA_INIT = 0.2f;
constexpr float QSCALE = 0.125f * 1.4426950408889634f;

typedef unsigned short bf16;
__device__ __forceinline__ unsigned f2bf(float f) { unsigned u = __builtin_bit_cast(unsigned, f); return (u + 0x7fffu + ((u >> 16) & 1u)) >> 16; }
__device__ __forceinline__ float bf2f(bf16 h) { return __builtin_bit_cast(float, (unsigned)h << 16); }
__device__ __forceinline__ unsigned pk2(float lo, float hi) { return f2bf(lo) | (f2bf(hi) << 16); }
__device__ __forceinline__ unsigned pk4_fp8(float a, float b, float c, float d) { int w = 0; w = __builtin_amdgcn_cvt_pk_fp8_f32(a, b, w, false); w = __builtin_amdgcn_cvt_pk_fp8_f32(c, d, w, true); return (unsigned)w; }
__device__ __forceinline__ float bflo(unsigned w) { return __builtin_bit_cast(float, w << 16); }
__device__ __forceinline__ float bfhi(unsigned w) { return __builtin_bit_cast(float, w & 0xffff0000u); }

constexpr size_t MiB = 1u << 20;
constexpr size_t WS_CTL = 0;
constexpr size_t WS_RSTD1 = 1 * MiB;
constexpr size_t WS_ROPE = 1 * MiB + 256 * 1024;
constexpr size_t WS_SELTOK = 1 * MiB + 512 * 1024;
constexpr size_t WS_SELGATE = 1 * MiB + 768 * 1024;
constexpr size_t WS_HID3 = 2 * MiB;
constexpr size_t WS_AFF = 3 * MiB;
constexpr size_t WS_WINT = 4 * MiB;
constexpr size_t WS_WPA = 15 * MiB, WS_WPH = 16 * MiB, WS_WO = 17 * MiB;
constexpr size_t WS_XB = 19 * MiB;
constexpr size_t WS_QN = 51 * MiB, WS_KN = 67 * MiB, WS_V = 83 * MiB;
constexpr size_t WS_HYT = 99 * MiB;
constexpr size_t WS_GATES = 147 * MiB;
constexpr size_t WS_ATTN = 211 * MiB, WS_HYENA = 131 * MiB;
constexpr size_t WS_TMPM = 243 * MiB, WS_MERGED = 51 * MiB;
constexpr size_t WS_HYT2 = 19 * MiB;
constexpr size_t WS_U2 = 83 * MiB;
constexpr size_t WS_WGU0 = 35 * MiB, WS_WGU1 = 227 * MiB;
constexpr size_t WS_WD0 = 4 * MiB, WS_WD1 = 275 * MiB;
constexpr size_t WS_HBUF = 99 * MiB;
constexpr size_t WS_INV = 15 * MiB;
constexpr size_t WS_SLAB = 147 * MiB;
constexpr size_t WS_FILT = 243 * MiB;
constexpr size_t WS_RSTD2 = 1 * MiB + 64 * 1024;
constexpr size_t WS_END = 283 * MiB;
constexpr size_t WS_KERNT = 19 * MiB;
constexpr size_t WS_Z0 = 243 * MiB;
constexpr size_t WS_Z1 = 51 * MiB;

struct P {
    const float *x, *norm1_g, *w_in, *scw, *scb, *qng, *kng, *lq1, *lk1, *lq2, *lk2, *subln, *fw1, *fb1, *fw2, *fb2, *fw3, *fb3, *fwo, *ffreq, *hskip, *wpa, *wph, *wo, *norm2_g, *wr, *wg, *wu, *wd;
    float* out; unsigned char* ws;
    int ph_lo, ph_hi;
};

__device__ __forceinline__ int opq_i(int x) { asm volatile("" : "+v"(x)); return x; }
__device__ __forceinline__ float wave_sum(float v) {
#pragma unroll
    for (int o = 1; o < 64; o <<= 1) v += __shfl_xor(v, o);
    return v;
}
__device__ __forceinline__ float static_max_log2(const P& p) {
    float mq = 0.f, mk = 0.f;
    for (int d = 0; d < 64; ++d) { mq = fmaxf(mq, fabsf(p.qng[d])); mk = fmaxf(mk, fabsf(p.kng[d])); }
    return 8.0f * mq * mk * 1.4426950408889634f * 1.01f + 0.05f;
}
__device__ __forceinline__ float calc_lam(const P& p) {
    float a = 0.f, c = 0.f;
    for (int d = 0; d < 64; ++d) { a += p.lq1[d] * p.lk1[d]; c += p.lq2[d] * p.lk2[d]; }
    return expf(a) - expf(c) + LAMBDA_INIT;
}
namespace pg8 {
#define PG8_LAS __attribute__((address_space(3)))
typedef unsigned short bf16_t;
typedef short bf16x8 __attribute__((ext_vector_type(8)));
typedef float f32x4 __attribute__((ext_vector_type(4)));
typedef unsigned u32x4 __attribute__((ext_vector_type(4)));
constexpr int BM = 256, BK = 64, HALF = 128, HTB = HALF * BK * 2  , STAGE_BYTES = 8 * HTB, NXCD = 8, WGM = 8;

__host__ __device__ __forceinline__ int lds_byte(int r, int c) { const int st = (r >> 4) * 2 + (c >> 5), rr = r & 15, cc = c & 31, ob = rr * 64 + cc * 2; return st * 1024 + (ob ^ (((ob >> 9) & 1) << 5)); }
__host__ __device__ __forceinline__ void stage_rc(int b, int& R, int& C) { const int st = b / 1024, sb = b % 1024, swz = sb ^ (((sb >> 9) & 1) << 5); R = (st >> 1) * 16 + swz / 64; C = (st & 1) * 32 + (swz % 64) / 2; }
__host__ __device__ __forceinline__ int perm32(int rho) { const int n = rho >> 4, i = rho & 15; return 8 * (i >> 2) + 4 * n + (i & 3); }

typedef int pg8_v4i __attribute__((ext_vector_type(4))); typedef int pg8_v8i __attribute__((ext_vector_type(8)));
__device__ __forceinline__ pg8_v8i pg8_cat(bf16x8 a, bf16x8 b) { return __builtin_shufflevector(__builtin_bit_cast(pg8_v4i, a), __builtin_bit_cast(pg8_v4i, b), 0, 1, 2, 3, 4, 5, 6, 7); }
struct Unit { int pm, pn, kind; };
struct Gemm { const bf16_t* A0; const bf16_t* B0; const bf16_t* A1; const bf16_t* B1; int K; };

struct StaticOrder {
    int nM, nN, nwg, G, c;
    __host__ __device__ void init(int M, int N, int G_, int c_) { nM = M / BM; nN = N / BM; nwg = nM * nN; G = G_; c = c_; }
    __host__ __device__ bool next(int i, Unit& u) const {
        const long L = (long)i * G + c; if (L >= nwg) return false;
        int wgid = (int)L; { const int q = nwg / NXCD, r = nwg % NXCD, xcd = wgid % NXCD, off = wgid / NXCD; wgid = (xcd < r ? xcd * (q + 1) : r * (q + 1) + (xcd - r) * q) + off; }
        const int nig = WGM * nN, gid = wgid / nig, fm = gid * WGM, gsz = (nM - fm) < WGM ? (nM - fm) : WGM;
        u.pm = fm + ((wgid % nig) % gsz); u.pn = (wgid % nig) / gsz; u.kind = 0; return true;
    }
    __device__ __forceinline__ void a_ready(const Unit&) const {}
    __device__ __forceinline__ void done(const Unit&) const {}
};

template <class Epi, class Sched, bool ALIGN_EPI = false, bool SP2 = false, bool GATHER = false, bool FP8 = false, int SCW = 127, int SCX = 127>
__device__ __forceinline__ void gemm_phase(PG8_LAS unsigned char* lds, const Gemm g, const Sched& S, const Epi& E, const int* gidx = nullptr) {
    const int tid = threadIdx.x, wid = __builtin_amdgcn_readfirstlane(tid >> 6), lane = tid & 63, wr = wid >> 2, wc = wid & 3, fr = lane & 15, fq = lane >> 4;
    constexpr int ESZ = FP8 ? 1 : 2;
    const int K = g.K, nt = K * ESZ / (BK * 2);
    unsigned voffA[2], voffB[2];
#pragma unroll
    for (int i = 0; i < 2; ++i) { int R, C; stage_rc(tid * 16 + i * 8192, R, C); const int Rb = Epi::PERM ? ((R & ~31) + perm32(R & 31)) : R;
        voffA[i] = (unsigned)(R * K) * (unsigned)ESZ + (unsigned)C * 2u; voffB[i] = (unsigned)(Rb * K) * (unsigned)ESZ + (unsigned)C * 2u; }
    int gR[2], gC[2];
#pragma unroll
    for (int i = 0; i < 2; ++i) stage_rc(tid * 16 + i * 8192, gR[i], gC[i]);
    unsigned cvo[2][2], nvo[2][2];
#define PG8_GOFF(dst, u) do { if constexpr (GATHER) { _Pragma("unroll") for (int h_ = 0; h_ < 2; ++h_) _Pragma("unroll") for (int i_ = 0; i_ < 2; ++i_) dst[h_][i_] = (unsigned)gidx[(u).pm * BM + h_ * HALF + gR[i_]] * (unsigned)K * (unsigned)ESZ + (unsigned)gC[i_] * 2u; } } while (0)
    const size_t kstep = (size_t)(BK * 2);
    const size_t hstep = (size_t)HALF * K * ESZ;
    const size_t tstep = 2 * hstep;
    const unsigned ldsw = (unsigned)wid * 1024u;
    const int aoff = lds_byte(wr * 64 + fr, FP8 ? fq * 16 : fq * 8), boff = lds_byte(wc * 32 + fr, FP8 ? fq * 16 : fq * 8);
    constexpr int KS = FP8 ? 16 : 1024;
#define PG8_SA(b, h) (((b) * 2 + (h)) * HTB)
#define PG8_SB(b, h) ((4 + (b) * 2 + (h)) * HTB)
#define PG8_STAGE(bufoff, gbase, voff) do { _Pragma("unroll") for (int _i = 0; _i < 2; ++_i) \
        __builtin_amdgcn_global_load_lds((const unsigned*)((const char*)(gbase) + (voff)[_i]), (PG8_LAS unsigned*)(lds + (bufoff) + ldsw + _i * 8192), 16, 0, 0); } while (0)
#define PG8_STAGE_A(bufoff, gptr, h, isnext) do { if constexpr (GATHER) { unsigned vo_[2]; vo_[0] = (isnext) ? nvo[h][0] : cvo[h][0]; vo_[1] = (isnext) ? nvo[h][1] : cvo[h][1]; PG8_STAGE(bufoff, gptr, vo_); } else { PG8_STAGE(bufoff, (gptr) + ((h) ? hstep : 0), voffA); } } while (0)
#define PG8_LDA(dst, b, h) do { _Pragma("unroll") for (int m = 0; m < 4; ++m) _Pragma("unroll") for (int k = 0; k < 2; ++k) dst[m][k] = *(const PG8_LAS bf16x8*)(lds + PG8_SA(b, h) + aoff + m * 2048 + k * KS); } while (0)
#define PG8_LDB(dst, b, h) do { _Pragma("unroll") for (int n = 0; n < 2; ++n) _Pragma("unroll") for (int k = 0; k < 2; ++k) dst[n][k] = *(const PG8_LAS bf16x8*)(lds + PG8_SB(b, h) + boff + n * 2048 + k * KS); } while (0)
#define PG8_MMA(ai, bj, At, Bt) do { __builtin_amdgcn_s_setprio(1); if constexpr (FP8) { _Pragma("unroll") for (int m = 0; m < 4; ++m) _Pragma("unroll") for (int n = 0; n < 2; ++n) \
        asm volatile("v_mfma_scale_f32_16x16x128_f8f6f4 %0, %1, %2, %0, %3, %4 op_sel_hi:[0,0,0]" : "+v"(acc[ai][bj][m][n]) : "v"(pg8_cat(Bt[n][0], Bt[n][1])), "v"(pg8_cat(At[m][0], At[m][1])), "v"(scw_), "v"(scx_)); } \
        else { _Pragma("unroll") for (int m = 0; m < 4; ++m) _Pragma("unroll") for (int n = 0; n < 2; ++n) _Pragma("unroll") for (int k = 0; k < 2; ++k) \
        acc[ai][bj][m][n] = __builtin_amdgcn_mfma_f32_16x16x32_bf16(Bt[n][k], At[m][k], acc[ai][bj][m][n], 0, 0, 0); } __builtin_amdgcn_s_setprio(0); } while (0)
#define PG8_WAIT_V(n) asm volatile("s_waitcnt vmcnt(" #n ")" ::: "memory")
#define PG8_WAIT_L(n) asm volatile("s_waitcnt lgkmcnt(" #n ")" ::: "memory")
#define PG8_BAR __builtin_amdgcn_s_barrier()
#define PG8_SCHED __builtin_amdgcn_sched_barrier(0)
    Unit cur, nxt; int ui = 0;
    if (!S.next(0, cur)) return;
    int scw_ = SCW * 0x01010101, scx_ = SCX * 0x01010101; asm volatile("" : "+v"(scw_), "+v"(scx_));
    f32x4 acc[2][2][4][2];
#pragma unroll
    for (int a = 0; a < 2; ++a)
#pragma unroll
        for (int b = 0; b < 2; ++b)
#pragma unroll
            for (int m = 0; m < 4; ++m)
#pragma unroll
                for (int n = 0; n < 2; ++n) acc[a][b][m][n] = (f32x4){0.f, 0.f, 0.f, 0.f};
    bf16x8 At[4][2], B0[2][2], B1[2][2];
    const char* cA = GATHER ? (const char*)g.A0 : (const char*)(cur.kind ? g.A1 : g.A0) + (size_t)cur.pm * tstep; PG8_GOFF(cvo, cur); const char* cB = (const char*)(cur.kind ? g.B1 : g.B0) + (size_t)cur.pn * tstep;
    S.a_ready(cur);
    if constexpr (SP2) {
        PG8_STAGE(PG8_SB(0, 0), cB, voffB); PG8_STAGE(PG8_SB(0, 1), cB + hstep, voffB); PG8_STAGE_A(PG8_SA(0, 0), cA, 0, false); PG8_STAGE_A(PG8_SA(0, 1), cA, 1, false);
        if (wr == 1) PG8_BAR;
        PG8_WAIT_V(2); PG8_BAR;
        PG8_STAGE(PG8_SB(1, 0), cB + kstep, voffB); PG8_STAGE_A(PG8_SA(1, 0), cA + kstep, 0, false); PG8_STAGE(PG8_SB(1, 1), cB + hstep + kstep, voffB);
        PG8_WAIT_V(6); PG8_BAR;
    } else {
        PG8_STAGE(PG8_SB(0, 0), cB, voffB); PG8_STAGE_A(PG8_SA(0, 0), cA, 0, false); PG8_STAGE(PG8_SB(0, 1), cB + hstep, voffB); PG8_STAGE_A(PG8_SA(0, 1), cA, 1, false);
        if (wr == 1) PG8_BAR;
        PG8_WAIT_V(4); PG8_BAR;
        PG8_STAGE(PG8_SB(1, 0), cB + kstep, voffB); PG8_STAGE_A(PG8_SA(1, 0), cA + kstep, 0, false); PG8_STAGE(PG8_SB(1, 1), cB + hstep + kstep, voffB);
        PG8_WAIT_V(6); PG8_BAR;
    }
    for (;;) {
        const bool has_next = S.next(ui + 1, nxt);
        const char* nA = GATHER ? cA : (has_next ? (const char*)(nxt.kind ? g.A1 : g.A0) + (size_t)nxt.pm * tstep : cA); if (has_next) PG8_GOFF(nvo, nxt); const char* nB = has_next ? (const char*)(nxt.kind ? g.B1 : g.B0) + (size_t)nxt.pn * tstep : cB;
#pragma unroll 1
        for (int t = 0; t < nt; t += 2) {
            const bool last = (t == nt - 2);
            const char* a1 = cA + (size_t)(t + 1) * kstep;
            const char* a2 = last ? nA : cA + (size_t)(t + 2) * kstep; const char* b2 = last ? nB : cB + (size_t)(t + 2) * kstep;
            const char* a3 = a2 + kstep; const char* b3 = b2 + kstep; const bool nx_ = last && has_next;
            if (last && has_next) S.a_ready(nxt);
            if constexpr (SP2) {
            PG8_LDB(B0, 0, 0); PG8_LDB(B1, 0, 1); PG8_SCHED; PG8_LDA(At, 0, 0); PG8_STAGE_A(PG8_SA(1, 1), a1, 1, false);
            PG8_WAIT_V(8); PG8_WAIT_L(0); PG8_BAR; PG8_MMA(0, 0, At, B0); PG8_MMA(0, 1, At, B1); PG8_BAR; PG8_SCHED;
            PG8_LDA(At, 0, 1); PG8_STAGE(PG8_SB(0, 0), b2, voffB); PG8_STAGE(PG8_SB(0, 1), b2 + hstep, voffB); PG8_STAGE_A(PG8_SA(0, 0), a2, 0, nx_);
            PG8_WAIT_V(8); PG8_WAIT_L(0); PG8_BAR; PG8_MMA(1, 0, At, B0); PG8_MMA(1, 1, At, B1); PG8_BAR; PG8_SCHED;
            PG8_LDB(B0, 1, 0); PG8_LDB(B1, 1, 1); PG8_SCHED; PG8_LDA(At, 1, 0); PG8_STAGE_A(PG8_SA(0, 1), a2, 1, nx_);
            PG8_WAIT_V(8); PG8_WAIT_L(0); PG8_BAR; PG8_MMA(0, 0, At, B0); PG8_MMA(0, 1, At, B1); PG8_BAR; PG8_SCHED;
            PG8_LDA(At, 1, 1); PG8_STAGE(PG8_SB(1, 0), b3, voffB); PG8_STAGE(PG8_SB(1, 1), b3 + hstep, voffB); PG8_STAGE_A(PG8_SA(1, 0), a3, 0, nx_);
            PG8_WAIT_V(8); PG8_WAIT_L(0); PG8_BAR; PG8_MMA(1, 0, At, B0); PG8_MMA(1, 1, At, B1); PG8_BAR; PG8_SCHED;
            } else {
            PG8_LDB(B0, 0, 0); PG8_SCHED; PG8_LDA(At, 0, 0); PG8_STAGE_A(PG8_SA(1, 1), a1, 1, false);
            PG8_WAIT_L(8); PG8_BAR; PG8_WAIT_L(0); PG8_MMA(0, 0, At, B0); PG8_BAR; PG8_SCHED;
            PG8_LDB(B1, 0, 1); PG8_STAGE(PG8_SB(0, 0), b2, voffB);
            PG8_BAR; PG8_WAIT_L(0); PG8_MMA(0, 1, At, B1); PG8_BAR;
            PG8_LDA(At, 0, 1); PG8_STAGE_A(PG8_SA(0, 0), a2, 0, nx_);
            PG8_BAR; PG8_WAIT_L(0); PG8_MMA(1, 0, At, B0); PG8_BAR; PG8_SCHED;
            PG8_STAGE(PG8_SB(0, 1), b2 + hstep, voffB);
            PG8_WAIT_V(6); PG8_BAR; PG8_MMA(1, 1, At, B1); PG8_BAR;
            PG8_LDB(B0, 1, 0); PG8_SCHED; PG8_LDA(At, 1, 0); PG8_STAGE_A(PG8_SA(0, 1), a2, 1, nx_);
            PG8_WAIT_L(8); PG8_BAR; PG8_WAIT_L(0); PG8_MMA(0, 0, At, B0); PG8_BAR; PG8_SCHED;
            PG8_LDB(B1, 1, 1); PG8_STAGE(PG8_SB(1, 0), b3, voffB);
            PG8_BAR; PG8_WAIT_L(0); PG8_MMA(0, 1, At, B1); PG8_BAR;
            PG8_LDA(At, 1, 1); PG8_STAGE_A(PG8_SA(1, 0), a3, 0, nx_);
            PG8_BAR; PG8_WAIT_L(0); PG8_MMA(1, 0, At, B0); PG8_BAR; PG8_SCHED;
            PG8_STAGE(PG8_SB(1, 1), b3 + hstep, voffB);
            PG8_WAIT_V(6); PG8_BAR; PG8_MMA(1, 1, At, B1); PG8_BAR;
            }
        }
        if constexpr (ALIGN_EPI) { if (wr == 0) PG8_BAR; }
        if constexpr (FP8) asm volatile("s_nop 15\n\ts_nop 7" ::: "memory");
        if constexpr (!Epi::AFTER_DRAIN) { int fr_ = fr, fq_ = fq; asm volatile("" : "+v"(fr_), "+v"(fq_)); if constexpr (Epi::REP > 1) { E(acc, cur, wr, wc, fr_, fq_); asm volatile("" ::: "memory"); } E(acc, cur, wr, wc, fr_, fq_); S.done(cur); }
        if (!has_next) break;
#pragma unroll
        for (int a = 0; a < 2; ++a)
#pragma unroll
            for (int b = 0; b < 2; ++b)
#pragma unroll
                for (int m = 0; m < 4; ++m)
#pragma unroll
                    for (int n = 0; n < 2; ++n) acc[a][b][m][n] = (f32x4){0.f, 0.f, 0.f, 0.f};
        cur = nxt; cA = nA; cB = nB; ++ui;
        if constexpr (GATHER) { _Pragma("unroll") for (int h_ = 0; h_ < 2; ++h_) _Pragma("unroll") for (int i_ = 0; i_ < 2; ++i_) cvo[h_][i_] = nvo[h_][i_]; }
        if constexpr (ALIGN_EPI) { if (wr == 1) PG8_BAR; }
    }
    PG8_WAIT_V(0);
    if constexpr (!ALIGN_EPI) { if (wr == 0) PG8_BAR; }
    PG8_BAR;
    if constexpr (Epi::AFTER_DRAIN) { E.fused(acc, cur, wr, wc, fr, fq, lds, wid, lane); S.done(cur); }
#undef PG8_SA
#undef PG8_SB
#undef PG8_STAGE
#undef PG8_STAGE_A
#undef PG8_GOFF
#undef PG8_LDA
#undef PG8_LDB
#undef PG8_MMA
#undef PG8_WAIT_V
#undef PG8_WAIT_L
#undef PG8_BAR
#undef PG8_SCHED
}
}
namespace pg8 {
typedef unsigned u32x2 __attribute__((ext_vector_type(2)));
__device__ __forceinline__ unsigned xcd_remap(int L_, int nwg) { const int q = nwg / NXCD, r = nwg % NXCD, xcd = L_ % NXCD, off = L_ / NXCD; return (unsigned)((xcd < r ? xcd * (q + 1) : r * (q + 1) + (xcd - r) * q) + off); }

struct SchedP1 {
    int G, c;
    __device__ bool next(int i, Unit& u) const {
        const int Lx = i * G + c; if (Lx >= 1280) return false;
        if (Lx < 896) { const int wgid = (int)xcd_remap(Lx, 896); const int nig = 8 * 14, gid = wgid / nig, fm = gid * 8; u.pm = fm + ((wgid % nig) % 8); u.pn = (wgid % nig) / 8; u.kind = 0; }
        else { const int wgid = (int)xcd_remap(Lx - 896, 384); u.pm = wgid % 6; u.pn = wgid / 6; u.kind = 1; }
        return true;
    }
    __device__ __forceinline__ void a_ready(const Unit&) const {}
    __device__ __forceinline__ void done(const Unit&) const {}
};
struct EpiInProj {
    static constexpr int REP = REP_EpiInProj;
    static constexpr bool PERM = true, AFTER_DRAIN = false;
    const float* rstd1; const float* rope; const float* gq; const float* gk;
    bf16_t *qn, *kn, *v, *hyT, *gates;
    __device__ __forceinline__ void operator()(const f32x4 (&acc)[2][2][4][2], const Unit& u, int wr, int wc, int fr, int fq) const {
        if (u.kind == 1) {
            const int tok0 = u.pn * BM, b = tok0 / L, l0 = tok0 % L;
            f32x4 rs[2][2];
#pragma unroll
            for (int bj = 0; bj < 2; ++bj)
#pragma unroll
                for (int n = 0; n < 2; ++n) rs[bj][n] = *(const f32x4*)(rstd1 + tok0 + bj * HALF + wc * 32 + 8 * fq + 4 * n);
#pragma unroll
            for (int ai = 0; ai < 2; ++ai)
#pragma unroll
                for (int m = 0; m < 4; ++m) {
                    const int r = u.pm * BM + ai * HALF + wr * 64 + m * 16 + fr;
                    bf16_t* rowp = hyT + ((size_t)b * HYC + r) * L + l0 + wc * 32 + 8 * fq;
#pragma unroll
                    for (int bj = 0; bj < 2; ++bj) { const f32x4 v0 = acc[ai][bj][m][0] * rs[bj][0], v1 = acc[ai][bj][m][1] * rs[bj][1];
                        u32x4 w; w.x = pk2(v0[0], v0[1]); w.y = pk2(v0[2], v0[3]); w.z = pk2(v1[0], v1[1]); w.w = pk2(v1[2], v1[3]);
                        __builtin_nontemporal_store(w, (u32x4*)(rowp + bj * HALF)); }
                }
            return;
        }
        const int row0 = u.pm * BM + wr * 64 + fr;
        if (u.pn < 4) {
            const int gidx = u.pn * 4 + wc, hm = gidx & 7; const bool isq = gidx < 8;
            const float* gain = isq ? gq : gk; bf16_t* dst = isq ? qn : kn;
            float gp[2][8];
#pragma unroll
            for (int bj = 0; bj < 2; ++bj)
#pragma unroll
                for (int t = 0; t < 8; ++t) { const int d = (bj == 0 && fq < 2) ? (4 * fq + (t >> 1) + 8 * (t & 1)) : (32 * bj + 8 * fq + t); gp[bj][t] = gain[d]; }
            const float sc = isq ? QSCALE : 1.0f;
#pragma unroll
            for (int ai = 0; ai < 2; ++ai)
#pragma unroll
                for (int m = 0; m < 4; ++m) {
                    const int tok = row0 + ai * HALF + m * 16, b = tok / L, l = tok % L;
                    const float rr = rstd1[tok];
                    float y[2][8]; float ss = 0.f;
#pragma unroll
                    for (int bj = 0; bj < 2; ++bj)
#pragma unroll
                        for (int t = 0; t < 8; ++t) { y[bj][t] = acc[ai][bj][m][t >> 2][t & 3] * rr; ss += y[bj][t] * y[bj][t]; }
                    ss += __shfl_xor(ss, 16); ss += __shfl_xor(ss, 32);
                    const float rn = 1.0f / sqrtf(ss * (1.0f / 64) + EPS);
#pragma unroll
                    for (int bj = 0; bj < 2; ++bj)
#pragma unroll
                        for (int t = 0; t < 8; ++t) y[bj][t] *= rn * gp[bj][t];
                    if (fq < 2) {
                        const f32x4 cs = *(const f32x4*)(rope + l * 8 + 4 * fq), sn = *(const f32x4*)(rope + L * 8 + l * 8 + 4 * fq);
#pragma unroll
                        for (int j = 0; j < 4; ++j) { const float a = y[0][2 * j], c = y[0][2 * j + 1]; y[0][2 * j] = a * cs[j] - c * sn[j]; y[0][2 * j + 1] = c * cs[j] + a * sn[j]; }
                    }
                    bf16_t* rowp = isq ? dst + (((size_t)b * 8 + hm) * L + l) * 64 + 8 * fq : dst + ((size_t)b * 8 + hm) * L * 64 + (size_t)(l >> 6) * 4096 + fq * 512 + (l & 63) * 8;
                    const int bstep = isq ? 32 : 2048;
#pragma unroll
                    for (int bj = 0; bj < 2; ++bj) { u32x4 w; w.x = pk2(y[bj][0] * sc, y[bj][1] * sc); w.y = pk2(y[bj][2] * sc, y[bj][3] * sc); w.z = pk2(y[bj][4] * sc, y[bj][5] * sc); w.w = pk2(y[bj][6] * sc, y[bj][7] * sc);
                        *(u32x4*)(rowp + bstep * bj) = w; }
                }
        } else if (u.pn < 6) {
#pragma unroll
            for (int ai = 0; ai < 2; ++ai)
#pragma unroll
                for (int m = 0; m < 4; ++m) {
                    const int tok = row0 + ai * HALF + m * 16, b = tok / L, l = tok % L; const float rr = rstd1[tok];
#pragma unroll
                    for (int bj = 0; bj < 2; ++bj) { const f32x4 v0 = acc[ai][bj][m][0] * rr, v1 = acc[ai][bj][m][1] * rr;
                        u32x4 w; w.x = pk2(v0[0], v0[1]); w.y = pk2(v0[2], v0[3]); w.z = pk2(v1[0], v1[1]); w.w = pk2(v1[2], v1[3]);
                        *(u32x4*)(v + ((size_t)b * NH + (u.pn - 4) * 2 + bj) * L * VD + (size_t)(l >> 6) * 8192 + wc * 2048 + ((l & 63) >> 4) * 512 + (l & 15) * 32 + 8 * fq) = w; }
                }
        } else {
#pragma unroll
            for (int ai = 0; ai < 2; ++ai)
#pragma unroll
                for (int m = 0; m < 4; ++m) {
                    const int tok = row0 + ai * HALF + m * 16; const float rr = rstd1[tok];
#pragma unroll
                    for (int bj = 0; bj < 2; ++bj) { float s[8];
#pragma unroll
                        for (int t = 0; t < 8; ++t) s[t] = __builtin_amdgcn_rcpf(1.0f + __builtin_amdgcn_exp2f(-1.4426950408889634f * rr * acc[ai][bj][m][t >> 2][t & 3]));
                        u32x4 w; w.x = pk2(s[0], s[1]); w.y = pk2(s[2], s[3]); w.z = pk2(s[4], s[5]); w.w = pk2(s[6], s[7]);
                        __builtin_nontemporal_store(w, (u32x4*)(gates + (size_t)tok * GC + (u.pn - 6) * BM + bj * HALF + wc * 32 + 8 * fq)); }
                }
        }
    }
};

struct SchedP3 {
    StaticOrder so;
    __device__ bool next(int i, Unit& u) const { if (i >= 2) return false; so.next(0, u); u.kind = i; return true; }
    __device__ __forceinline__ void a_ready(const Unit&) const {}
    __device__ __forceinline__ void done(const Unit&) const {}
};
struct EpiMerge {
    static constexpr int REP = REP_EpiMerge;
    static constexpr bool PERM = true, AFTER_DRAIN = false;
    const bf16_t* gates; bf16_t* tmpm; bf16_t* merged;
    __device__ __forceinline__ void operator()(const f32x4 (&acc)[2][2][4][2], const Unit& u, int wr, int wc, int fr, int fq) const {
        const int row0 = u.pm * BM + wr * 64 + fr, col0 = u.pn * BM + wc * 32 + 8 * fq;
#pragma unroll
        for (int ai = 0; ai < 2; ++ai) {
            u32x4 g[4][2], pr[4][2];
#pragma unroll
            for (int m = 0; m < 4; ++m)
#pragma unroll
                for (int bj = 0; bj < 2; ++bj) { const int tok = row0 + ai * HALF + m * 16, col = col0 + bj * HALF;
                    g[m][bj] = *(const u32x4*)(gates + (size_t)tok * GC + u.kind * 1024 + col);
                    if (u.kind == 1) pr[m][bj] = *(const u32x4*)(tmpm + (size_t)tok * D + col); }
#pragma unroll
            for (int m = 0; m < 4; ++m)
#pragma unroll
                for (int bj = 0; bj < 2; ++bj) { const int tok = row0 + ai * HALF + m * 16, col = col0 + bj * HALF;
                    float o[8];
#pragma unroll
                    for (int t = 0; t < 4; ++t) { o[2 * t] = bflo(g[m][bj][t]) * acc[ai][bj][m][t >> 1][(2 * t) & 3]; o[2 * t + 1] = bfhi(g[m][bj][t]) * acc[ai][bj][m][t >> 1][(2 * t + 1) & 3]; }
                    if (u.kind == 1) {
#pragma unroll
                        for (int t = 0; t < 4; ++t) { o[2 * t] += bflo(pr[m][bj][t]); o[2 * t + 1] += bfhi(pr[m][bj][t]); } }
                    u32x4 w; w.x = pk2(o[0], o[1]); w.y = pk2(o[2], o[3]); w.z = pk2(o[4], o[5]); w.w = pk2(o[6], o[7]);
                    *(u32x4*)((u.kind == 1 ? merged : tmpm) + (size_t)tok * D + col) = w; }
        }
    }
};

struct EpiOutProj {
    static constexpr int REP = REP_EpiOutProj;
    static constexpr bool PERM = false, AFTER_DRAIN = false;
    const float* x; float* out;
    __device__ __forceinline__ void operator()(const f32x4 (&acc)[2][2][4][2], const Unit& u, int wr, int wc, int fr, int fq) const {
        const int row0 = u.pm * BM + wr * 64 + fr, col0 = u.pn * BM + wc * 32 + 4 * fq;
#pragma unroll
        for (int ai = 0; ai < 2; ++ai) {
            f32x4 xv[4][2][2];
#pragma unroll
            for (int m = 0; m < 4; ++m)
#pragma unroll
                for (int bj = 0; bj < 2; ++bj)
#pragma unroll
                    for (int n = 0; n < 2; ++n) xv[m][bj][n] = __builtin_nontemporal_load((const f32x4*)(x + (size_t)(row0 + ai * HALF + m * 16) * D + col0 + bj * HALF + n * 16));
#pragma unroll
            for (int m = 0; m < 4; ++m)
#pragma unroll
                for (int bj = 0; bj < 2; ++bj)
#pragma unroll
                    for (int n = 0; n < 2; ++n) *(f32x4*)(out + (size_t)(row0 + ai * HALF + m * 16) * D + col0 + bj * HALF + n * 16) = xv[m][bj][n] + acc[ai][bj][m][n];
        }
    }
};

struct SchedP7 {
    int G, c;
    __device__ bool next(int i, Unit& u) const {
        const int Lx = i * G + c; if (Lx >= 1024) return false;
        const int wgid = (int)xcd_remap(Lx, 1024), e = wgid >> 6, wl = wgid & 63, pmi = wl & 7, pni = ((wl >> 3) & 3) + 4 * (wl >> 5);
        u.pm = ((pmi >> 1) * 16 + e) * 2 + (pmi & 1); u.pn = e * 8 + pni; u.kind = e >> 3; return true;
    }
    __device__ __forceinline__ void a_ready(const Unit&) const {}
    __device__ __forceinline__ void done(const Unit&) const {}
};
struct EpiGateUp {
    static constexpr int REP = REP_EpiGateUp;
    static constexpr bool PERM = true, AFTER_DRAIN = false;
    unsigned char* hbuf;
    __device__ __forceinline__ void operator()(const f32x4 (&acc)[2][2][4][2], const Unit& u, int wr, int wc, int fr, int fq) const {
        const int row0 = u.pm * BM + wr * 64 + fr, col0 = (u.pn & 7) * HALF + wc * 32 + 8 * fq;
#pragma unroll
        for (int ai = 0; ai < 2; ++ai)
#pragma unroll
            for (int m = 0; m < 4; ++m) { float h[8];
#pragma unroll
                for (int t = 0; t < 8; ++t) { const float g = acc[ai][0][m][t >> 2][t & 3], up = acc[ai][1][m][t >> 2][t & 3];
                    h[t] = fminf(fmaxf(g * __builtin_amdgcn_rcpf(1.0f + __builtin_amdgcn_exp2f(-1.4426950408889634f * g)) * up, -448.f), 448.f); }
                u32x2 w; w.x = pk4_fp8(h[0], h[1], h[2], h[3]); w.y = pk4_fp8(h[4], h[5], h[6], h[7]);
                *(u32x2*)(hbuf + (size_t)(row0 + ai * HALF + m * 16) * EH + col0) = w; }
    }
};
struct SchedP8 {
    int G, c;
    __device__ bool next(int i, Unit& u) const {
        const int Lx = i * G + c; if (Lx >= 512) return false;
        const int wgid = (int)xcd_remap(Lx, 512), e = wgid >> 5, wl = wgid & 31, pmi = wl & 7, pni = wl >> 3;
        u.pm = ((pmi >> 1) * 16 + e) * 2 + (pmi & 1); u.pn = e * 4 + pni; u.kind = e >> 3; return true;
    }
    __device__ __forceinline__ void a_ready(const Unit&) const {}
    __device__ __forceinline__ void done(const Unit&) const {}
};
struct EpiDown {
    static constexpr int REP = REP_EpiDown;
    static constexpr bool PERM = true, AFTER_DRAIN = false;
    const float* selgate; bf16_t* slab;
    __device__ __forceinline__ void operator()(const f32x4 (&acc)[2][2][4][2], const Unit& u, int wr, int wc, int fr, int fq) const {
        const int row0 = u.pm * BM + wr * 64 + fr, col0 = (u.pn & 3) * BM + wc * 32 + 8 * fq;
        float gts[8];
#pragma unroll
        for (int r = 0; r < 8; ++r) gts[r] = selgate[row0 + (r >> 2) * HALF + (r & 3) * 16];
#pragma unroll
        for (int ai = 0; ai < 2; ++ai)
#pragma unroll
            for (int m = 0; m < 4; ++m) { const int row = row0 + ai * HALF + m * 16; const float gt = gts[ai * 4 + m];
#pragma unroll
                for (int bj = 0; bj < 2; ++bj) { const f32x4 v0 = acc[ai][bj][m][0] * gt, v1 = acc[ai][bj][m][1] * gt;
                    u32x4 w; w.x = pk2(v0[0], v0[1]); w.y = pk2(v0[2], v0[3]); w.z = pk2(v1[0], v1[1]); w.w = pk2(v1[2], v1[3]);
                    *(u32x4*)(slab + (size_t)row * D + col0 + bj * HALF) = w; } }
    }
};
}
namespace attn {
typedef short bf16x8 __attribute__((ext_vector_type(8)));
typedef short s16x4 __attribute__((ext_vector_type(4)));
typedef float f32x16 __attribute__((ext_vector_type(16)));
typedef unsigned u32x4 __attribute__((ext_vector_type(4)));
typedef float f32x2_t __attribute__((ext_vector_type(2))); typedef __bf16 bf16x2_t __attribute__((ext_vector_type(2)));
typedef __attribute__((address_space(3))) const char* lds_cptr;
typedef short v4i16_t __attribute__((ext_vector_type(4)));
constexpr int SLOT = 32768, NSLOT = 3, OFF_K1 = 0, OFF_K2 = 8192, OFF_V = 16384;
constexpr int OFF_TB = 98304;
constexpr int OFF_X = 0, OFF_STG = 65536, OFF_WSF = 98304;
__device__ __forceinline__ int crow(int r, int hi) { return (r & 3) + 8 * (r >> 2) + 4 * hi; }
__device__ __forceinline__ void glds16(const void* gsrc, unsigned lds_dst) { unsigned keep;
    asm volatile("s_mov_b32 %0, m0\n\ts_mov_b32 m0, %2\n\ts_nop 0\n\tglobal_load_lds_dwordx4 %1, off\n\ts_mov_b32 m0, %0" : "=&s"(keep) : "v"(gsrc), "s"(lds_dst) : "memory"); }
__device__ __forceinline__ void glds16s(const void* sbase, unsigned voff, unsigned lds_dst) { unsigned keep;
    asm volatile("s_mov_b32 %0, m0\n\ts_mov_b32 m0, %3\n\ts_nop 0\n\tglobal_load_lds_dwordx4 %1, %2\n\ts_mov_b32 m0, %0" : "=&s"(keep) : "v"(voff), "s"(sbase), "s"(lds_dst) : "memory"); }
__device__ __forceinline__ void glds16s_nt(const void* sbase, unsigned voff, unsigned lds_dst) { unsigned keep;
    asm volatile("s_mov_b32 %0, m0\n\ts_mov_b32 m0, %3\n\ts_nop 0\n\tglobal_load_lds_dwordx4 %1, %2 nt\n\ts_mov_b32 m0, %0" : "=&s"(keep) : "v"(voff), "s"(sbase), "s"(lds_dst) : "memory"); }
struct WConv { const float* wg; const float* wu; const float* wd; unsigned char* ws; int blk; };
__device__ __forceinline__ unsigned cvtpk(float lo, float hi) { f32x2_t v = {lo, hi}; bf16x2_t b = __builtin_convertvector(v, bf16x2_t); return __builtin_bit_cast(unsigned, b); }
__device__ __forceinline__ s16x4 vtr(lds_cptr p) { return __builtin_bit_cast(s16x4, __builtin_amdgcn_ds_read_tr16_b64_v4i16((__attribute__((address_space(3))) v4i16_t*)p)); }
#define ATT_WAIT_BAR(N) asm volatile("s_waitcnt vmcnt(" #N ") lgkmcnt(0)\n\ts_barrier" ::: "memory")

__device__ __forceinline__ void attn_unit(int b, int h, int qb, const bf16* qn, const bf16* kn, const bf16* vv, bf16* attn_out, const float* subln, float M2, float lam,
                                          __attribute__((address_space(3))) unsigned char* lds, const WConv wc) {
    const int tid = threadIdx.x, lane = tid & 63, r32 = lane & 31, hi = lane >> 5; const int wid = __builtin_amdgcn_readfirstlane(tid >> 6);
    const unsigned lds0 = (unsigned)(uintptr_t)lds;
    const bf16* k1b = kn + (((size_t)b * 8 + h * 2 + 0) * L) * 64 + wid * 512;
    const bf16* k2b = kn + (((size_t)b * 8 + h * 2 + 1) * L) * 64 + wid * 512;
    const bf16* v0b = vv + (((size_t)b * NH + h) * L) * VD + wid * 512;
    const bf16* v1b = v0b + 8 * 512;
    const unsigned lofs = (unsigned)lane * 16u;
#define ATT_DMA(t, slot) do { \
        glds16s(k1b + (size_t)(t) * 64 * 64, lofs, (unsigned)__builtin_amdgcn_readfirstlane(lds0 + (slot) + OFF_K1 + wid * 1024)); \
        glds16s(k2b + (size_t)(t) * 64 * 64, lofs, (unsigned)__builtin_amdgcn_readfirstlane(lds0 + (slot) + OFF_K2 + wid * 1024)); \
        glds16s(v0b + (size_t)(t) * 64 * VD, lofs, (unsigned)__builtin_amdgcn_readfirstlane(lds0 + (slot) + OFF_V + wid * 1024)); \
        glds16s(v1b + (size_t)(t) * 64 * VD, lofs, (unsigned)__builtin_amdgcn_readfirstlane(lds0 + (slot) + OFF_V + (wid + 8) * 1024)); } while (0)
    constexpr int NT = L / 64;
    ATT_DMA(0, 0); ATT_DMA(1, SLOT);
    const int q0 = qb * 256 + wid * 32;
    const bf16* Q1 = qn + (((size_t)b * 8 + h * 2 + 0) * L + q0) * 64; const bf16* Q2 = qn + (((size_t)b * 8 + h * 2 + 1) * L + q0) * 64;
    bf16x8 qa[4], qc[4];
    { const int lq = opq_i(lane); const unsigned qoff = (unsigned)((lq & 31) * 64 + (lq >> 5) * 8);
#pragma unroll
    for (int d0 = 0; d0 < 4; ++d0) { qa[d0] = *reinterpret_cast<const bf16x8*>(Q1 + qoff + d0 * 16); qc[d0] = *reinterpret_cast<const bf16x8*>(Q2 + qoff + d0 * 16); } }
    const float shift = M2 > 64.f ? M2 : 0.f; const bool shifted = __builtin_amdgcn_readfirstlane(__float_as_int(shift)) != 0;
    f32x16 o1[4], o2[4];
#pragma unroll
    for (int d = 0; d < 4; ++d) { o1[d] = f32x16{}; o2[d] = f32x16{}; }
    float l1 = 0.f, l2 = 0.f;
    const lds_cptr lds3 = (lds_cptr)lds;
    const lds_cptr kp0 = lds3 + hi * 1024 + r32 * 16;
    const lds_cptr vp0 = lds3 + OFF_V + ((lane >> 4) & 1) * 32 + (lane & 3) * 8 + (4 * hi + ((lane & 15) >> 2)) * 64;
    int sl_cur = 0, sl_nn = 2 * SLOT;
    int tb_w = 0;
#define WC_DECODE(J) do { const int tau = wc.blk * 48 + (J); \
        if (tau < 8192) { e = tau >> 9; const int r_ = tau & 511; kb = (r_ >> 5) & 7; nb = r_ & 31; srcm = (r_ >> 8) ? wc.wu : wc.wg; } \
        else { const int t2_ = tau - 8192; e = t2_ >> 8; const int r_ = t2_ & 255; kb = r_ >> 5; nb = r_ & 31; srcm = wc.wd; } } while (0)
#define ATT_QK(P0, P1, KOFF, QR) do { const lds_cptr kp_ = kp0 + sl_cur + (KOFF); _Pragma("unroll") for (int d0 = 0; d0 < 4; ++d0) { \
            const bf16x8 b0_ = *(const __attribute__((address_space(3))) bf16x8*)(kp_ + d0 * 2048); \
            const bf16x8 b1_ = *(const __attribute__((address_space(3))) bf16x8*)(kp_ + d0 * 2048 + 512); \
            if (d0 == 0) { P0 = __builtin_amdgcn_mfma_f32_32x32x16_bf16(b0_, QR[0], f32x16{}, 0, 0, 0); P1 = __builtin_amdgcn_mfma_f32_32x32x16_bf16(b1_, QR[0], f32x16{}, 0, 0, 0); } \
            else { P0 = __builtin_amdgcn_mfma_f32_32x32x16_bf16(b0_, QR[d0], P0, 0, 0, 0); P1 = __builtin_amdgcn_mfma_f32_32x32x16_bf16(b1_, QR[d0], P1, 0, 0, 0); } } } while (0)
#define ATT_SM(P0, P1, LS, PW) do { float sa_ = 0.f, sb_ = 0.f; if (shifted) { _Pragma("unroll") for (int r = 0; r < 16; ++r) { P0[r] -= shift; P1[r] -= shift; } } _Pragma("unroll") for (int r = 0; r < 16; ++r) { P0[r] = __builtin_amdgcn_exp2f(P0[r]); P1[r] = __builtin_amdgcn_exp2f(P1[r]); sa_ += P0[r]; sb_ += P1[r]; } LS += sa_ + sb_; \
        _Pragma("unroll") for (int i = 0; i < 4; ++i) { PW[0][i] = cvtpk(P0[2 * i], P0[2 * i + 1]); PW[1][i] = cvtpk(P0[8 + 2 * i], P0[9 + 2 * i]); PW[2][i] = cvtpk(P1[2 * i], P1[2 * i + 1]); PW[3][i] = cvtpk(P1[8 + 2 * i], P1[9 + 2 * i]); } } while (0)
    for (int t = 0; t < NT; ++t) {
        if (t == 0) { ATT_WAIT_BAR(4); } else if (t <= 48) { ATT_WAIT_BAR(6); } else if (t + 1 < NT) { ATT_WAIT_BAR(4); } else { ATT_WAIT_BAR(0); }
        if (t + 2 < NT) ATT_DMA(t + 2, sl_nn);
        u32x4 pwa[4], pwc[4];
        { f32x16 pa0, pa1; ATT_QK(pa0, pa1, OFF_K1, qa); ATT_SM(pa0, pa1, l1, pwa); }
        asm volatile("" : "+v"(pwa[0]), "+v"(pwa[1]), "+v"(pwa[2]), "+v"(pwa[3]), "+v"(l1));
        { f32x16 pc0, pc1; ATT_QK(pc0, pc1, OFF_K2, qc); ATT_SM(pc0, pc1, l2, pwc); }
        const lds_cptr vp = vp0 + sl_cur;
#pragma unroll
        for (int db = 0; db < 4; ++db) {
            if (db == 2) {
            if (t >= 2 && t < 50) {
                int e, kb, nb; const float* srcm;
                WC_DECODE(t - 2);
                const bool gu = srcm != wc.wd;
                const int drow0 = gu ? (nb >> 2) * 256 + (srcm == wc.wu ? 128 : 0) + (nb & 3) * 32 : nb * 32;
                const size_t dofs = gu ? (e < 8 ? WS_WGU0 : WS_WGU1) + (size_t)(e & 7) * (2 * MiB) : (e < 8 ? WS_WD0 : WS_WD1) + (size_t)(e & 7) * MiB;
                const int lr = opq_i(lane);
                const unsigned tpa = lds0 + OFF_TB + tb_w + wid * 2048 + (lr >> 5) * 1024 + (lr & 31) * 4;
                float v[8];
                asm volatile("ds_read2_b32 %0, %4 offset1:32\n\tds_read2_b32 %1, %4 offset0:64 offset1:96\n\tds_read2_b32 %2, %4 offset0:128 offset1:160\n\tds_read2_b32 %3, %4 offset0:192 offset1:224\n\ts_waitcnt lgkmcnt(0)"
                             : "=&v"(*(f32x2_t*)&v[0]), "=&v"(*(f32x2_t*)&v[2]), "=&v"(*(f32x2_t*)&v[4]), "=&v"(*(f32x2_t*)&v[6]) : "v"(tpa) : "memory");
    #pragma unroll
                for (int i = 0; i < 8; ++i) v[i] *= 32.0f;
                uint2 o; o.x = pk4_fp8(v[0], v[1], v[2], v[3]); o.y = pk4_fp8(v[4], v[5], v[6], v[7]);
                *(uint2*)(wc.ws + dofs + (size_t)(drow0 * 1024 + kb * 128 + wid * 16) + (unsigned)((lr & 31) * 1024 + (lr >> 5) * 8)) = o;
            }
            if (t < 48) {
                int e, kb, nb; const float* srcm;
                WC_DECODE(t);
                const float* s = srcm + (size_t)e * (D * EH) + (size_t)(kb * 128 + wid * 16) * 1024 + nb * 32;
                const int lw = opq_i(lane); const unsigned voff = (unsigned)(((lw >> 3) * 1024 + (lw & 7) * 4) * 4);
                const unsigned dst = lds0 + OFF_TB + tb_w + wid * 2048;
                glds16s_nt(s, voff, (unsigned)__builtin_amdgcn_readfirstlane(dst)); glds16s_nt(s + 8 * 1024, voff, (unsigned)__builtin_amdgcn_readfirstlane(dst + 1024));
            }
                tb_w ^= 16384;
            }
#pragma unroll
            for (int ks = 0; ks < 4; ++ks) {
                const s16x4 lo = vtr(vp + db * 4096 + ks * 1024), hh = vtr(vp + db * 4096 + ks * 1024 + 512);
                const bf16x8 vf = (bf16x8){lo[0], lo[1], lo[2], lo[3], hh[0], hh[1], hh[2], hh[3]};
                o1[db] = __builtin_amdgcn_mfma_f32_32x32x16_bf16(__builtin_bit_cast(bf16x8, pwa[ks]), vf, o1[db], 0, 0, 0);
                o2[db] = __builtin_amdgcn_mfma_f32_32x32x16_bf16(__builtin_bit_cast(bf16x8, pwc[ks]), vf, o2[db], 0, 0, 0);
            }
        }
        sl_cur = (sl_cur == (NSLOT - 1) * SLOT) ? 0 : sl_cur + SLOT;
        sl_nn = (sl_nn == (NSLOT - 1) * SLOT) ? 0 : sl_nn + SLOT;
    }
#undef ATT_QK
#undef WC_DECODE
#undef ATT_SM
    const int lane_e = opq_i(lane), r32e = lane_e & 31, hie = lane_e >> 5;
    { auto rr = __builtin_amdgcn_permlane32_swap(__float_as_uint(l1), __float_as_uint(l1), false, false); l1 = __uint_as_float(rr[0]) + __uint_as_float(rr[1]); }
    { auto rr = __builtin_amdgcn_permlane32_swap(__float_as_uint(l2), __float_as_uint(l2), false, false); l2 = __uint_as_float(rr[0]) + __uint_as_float(rr[1]); }
    __attribute__((address_space(3))) float* wsf = (__attribute__((address_space(3))) float*)(lds + OFF_WSF) + wid * 64;
    asm volatile("s_waitcnt lgkmcnt(0)\n\ts_barrier" ::: "memory");
    if (hie == 0) { wsf[r32e] = __builtin_amdgcn_rcpf(l1); wsf[32 + r32e] = lam * __builtin_amdgcn_rcpf(l2); }
    asm volatile("s_waitcnt lgkmcnt(0)" ::: "memory");
    float ss[16];
#pragma unroll
    for (int r = 0; r < 16; ++r) { const float c1 = wsf[crow(r, hie)], c2 = wsf[32 + crow(r, hie)]; float s = 0.f;
#pragma unroll
        for (int db = 0; db < 4; ++db) { const float val = o1[db][r] * c1 - o2[db][r] * c2; o1[db][r] = val; s += val * val; }
        s += __shfl_xor(s, 1); s += __shfl_xor(s, 2); s += __shfl_xor(s, 4); s += __shfl_xor(s, 8); s += __shfl_xor(s, 16);
        ss[r] = (1.0f - LAMBDA_INIT) / sqrtf(s * (1.0f / 128) + EPS); }
    __attribute__((address_space(3))) bf16* stg = (__attribute__((address_space(3))) bf16*)(lds + OFF_X) + wid * 4096;
#pragma unroll
    for (int db = 0; db < 4; ++db) { const float gg = subln[db * 32 + r32e];
#pragma unroll
        for (int r = 0; r < 16; ++r) stg[crow(r, hie) * 128 + db * 32 + r32e] = (bf16)f2bf(o1[db][r] * ss[r] * gg); }
    asm volatile("s_waitcnt lgkmcnt(0)" ::: "memory");
    bf16* Ow = attn_out + ((size_t)b * L + q0) * AW + h * VD;
#pragma unroll
    for (int i = 0; i < 8; ++i) { const int row = i * 4 + (lane_e >> 4), ch = lane_e & 15;
        const u32x4 val = *(const __attribute__((address_space(3))) u32x4*)(stg + row * 128 + ch * 8);
        *(u32x4*)(Ow + (size_t)row * AW + ch * 8) = val; }
    asm volatile("s_waitcnt lgkmcnt(0)\n\ts_barrier" ::: "memory");
#undef ATT_DMA
}
#undef ATT_WAIT_BAR
}
namespace hy {
typedef float f32x2 __attribute__((ext_vector_type(2)));
typedef float f32x4v __attribute__((ext_vector_type(4)));
#define HLAS __attribute__((address_space(3)))
constexpr int N = 8192, OFF_BUF = 0, OFF_H1 = 69632, OFF_H2 = 69632 + 32832, HY_LDS_END = 69632 + 2 * 32832;
__device__ __forceinline__ int phys(int i) { return i + (i >> 4); }
__device__ __forceinline__ int opq(int x) { asm volatile("" : "+v"(x)); return x; }
__device__ __forceinline__ f32x2 cmul(f32x2 a, f32x2 b) { return (f32x2){a.x * b.x - a.y * b.y, a.x * b.y + a.y * b.x}; }
__device__ __forceinline__ f32x2 cmulc(f32x2 a, f32x2 b) { return (f32x2){a.x * b.x + a.y * b.y, a.y * b.x - a.x * b.y}; }
__device__ __forceinline__ f32x2 twid(float frac) { return (f32x2){__builtin_amdgcn_cosf(frac), __builtin_amdgcn_sinf(frac)}; }
__device__ __forceinline__ f32x2 mul_mi(f32x2 a) { return (f32x2){a.y, -a.x}; }
#define HY_FFT4(a0, a1, a2, a3, r0, r1, r2, r3) do { const f32x2 t0_ = a0 + a2, t1_ = a0 - a2, t2_ = a1 + a3, t3_ = mul_mi(a1 - a3); r0 = t0_ + t2_; r1 = t1_ + t3_; r2 = t0_ - t2_; r3 = t1_ - t3_; } while (0)
__device__ __forceinline__ void fft16(const f32x2 (&u)[16], f32x2 (&v)[16]) {
    constexpr float C1 = 0.92387953251128674f, S1 = 0.38268343236508977f, R2 = 0.70710678118654752f;
    f32x2 y[16];
#pragma unroll
    for (int n1 = 0; n1 < 4; ++n1) HY_FFT4(u[n1], u[n1 + 4], u[n1 + 8], u[n1 + 12], y[n1], y[n1 + 4], y[n1 + 8], y[n1 + 12]);
    y[5] = cmul(y[5], (f32x2){C1, -S1});  y[9] = cmul(y[9], (f32x2){R2, -R2});   y[13] = cmul(y[13], (f32x2){S1, -C1});
    y[6] = cmul(y[6], (f32x2){R2, -R2});  y[10] = mul_mi(y[10]);                 y[14] = cmul(y[14], (f32x2){-R2, -R2});
    y[7] = cmul(y[7], (f32x2){S1, -C1});  y[11] = cmul(y[11], (f32x2){-R2, -R2}); y[15] = cmul(y[15], (f32x2){-C1, S1});
#pragma unroll
    for (int k2 = 0; k2 < 4; ++k2) HY_FFT4(y[4 * k2], y[4 * k2 + 1], y[4 * k2 + 2], y[4 * k2 + 3], v[k2], v[4 + k2], v[8 + k2], v[12 + k2]);
}
__device__ __forceinline__ void load16(const HLAS f32x2* buf, int tid, f32x2 (&u)[16]) {
    const HLAS f32x2* b = buf + phys(tid);
#pragma unroll
    for (int r = 0; r < 16; ++r) u[r] = b[544 * r];
}
template <int PS> __device__ __forceinline__ void store16(HLAS f32x2* buf, int j, const f32x2 (&v)[16]) {
    HLAS f32x2* b = buf + phys(j);
#pragma unroll
    for (int r = 0; r < 16; ++r) b[PS * r] = v[r];
}
__device__ __forceinline__ void twiddle16(f32x2 (&u)[16], int k, float inv_pr) {
    const f32x2 w1 = twid(-(float)k * inv_pr); f32x2 w = w1;
#pragma unroll
    for (int r = 1; r < 16; ++r) { u[r] = cmul(u[r], w); w = cmul(w, w1); }
}
__device__ __forceinline__ void passes_bc(HLAS f32x2* buf, int tid_) {
    f32x2 u[16], v[16];
    int tid = opq(tid_);
    load16(buf, tid, u); __syncthreads();
    { const int k = tid & 15; twiddle16(u, k, 1.0f / 256.0f); fft16(u, v); store16<17>(buf, (tid - k) * 16 + k, v); }
    __syncthreads();
    tid = opq(tid_);
    load16(buf, tid, u); __syncthreads();
    { const int k = tid & 255; twiddle16(u, k, 1.0f / 4096.0f); fft16(u, v); store16<272>(buf, (tid - k) * 16 + k, v); }
    __syncthreads();
}
__device__ __forceinline__ void fft_lds(HLAS f32x2* buf, int tid_) {
    int tid = opq(tid_);
    { f32x2 u[16], v[16]; load16(buf, tid, u); __syncthreads(); fft16(u, v); store16<1>(buf, tid * 16, v); }
    __syncthreads();
    passes_bc(buf, tid_);
    tid = opq(tid_);
    { HLAS f32x2* b = buf + phys(tid);
#pragma unroll
    for (int q = 0; q < 8; ++q) { const int ii = tid + 512 * q; const f32x2 a = b[544 * q], c = cmul(b[544 * (q + 8)], twid(-(float)ii * (1.0f / 8192.0f)));
        b[544 * q] = a + c; b[544 * (q + 8)] = a - c; } }
    __syncthreads();
}
__device__ __forceinline__ void conv_apply(HLAS f32x2* buf, const HLAS f32x2* Hh, int tid, const float (&zr)[8], const float (&zi)[8], float (&yr)[8], float (&yi)[8]) {
    const int tid_ = tid;
    __syncthreads();
    tid = opq(tid_);
    { f32x2 u[16], v[16];
#pragma unroll
      for (int r = 0; r < 8; ++r) { u[r] = (f32x2){zr[r], zi[r]}; u[r + 8] = (f32x2){0.f, 0.f}; }
      fft16(u, v); store16<1>(buf, tid * 16, v); }
    __syncthreads();
    passes_bc(buf, tid_);
    tid = opq(tid_);
    { HLAS f32x2* b = buf + phys(tid); const HLAS f32x2* ha = Hh + tid; const HLAS f32x2* hb = Hh + (4096 - 512 * 7) - tid;
#pragma unroll
    for (int q = 0; q < 8; ++q) { const int ii = tid + 512 * q; const f32x2 a = b[544 * q], c = cmul(b[544 * (q + 8)], twid(-(float)ii * (1.0f / 8192.0f)));
        const f32x2 d0 = a + c, d1 = a - c, h0 = ha[512 * q], h1 = hb[512 * (7 - q)];
        const f32x2 y0 = cmul(d0, h0), y1 = cmulc(d1, h1);
        b[544 * q] = (f32x2){y0.x, -y0.y}; b[544 * (q + 8)] = (f32x2){y1.x, -y1.y}; } }
    __syncthreads();
    tid = opq(tid_);
    { f32x2 u[16], v[16]; load16(buf, tid, u); __syncthreads(); fft16(u, v); store16<1>(buf, tid * 16, v); }
    __syncthreads();
    passes_bc(buf, tid_);
    tid = opq(tid_);
    { const HLAS f32x2* b = buf + phys(tid);
#pragma unroll
    for (int q = 0; q < 8; ++q) { const int ii = tid + 512 * q; const f32x2 a = b[544 * q], c = cmul(b[544 * (q + 8)], twid(-(float)ii * (1.0f / 8192.0f)));
        const f32x2 r = a + c; yr[q] = r.x; yi[q] = -r.y; } }
}
typedef unsigned u32x4s __attribute__((ext_vector_type(4)));
struct RowPair { u32x4s a, b; };
__device__ __forceinline__ RowPair rows_load(const bf16* r0, const bf16* r1, int tid) { RowPair r; r.a = __builtin_nontemporal_load((const u32x4s*)r0 + tid); r.b = __builtin_nontemporal_load((const u32x4s*)r1 + tid); return r; }
__device__ __forceinline__ void sconv_pair(const RowPair& rp, HLAS unsigned short* stg, int tid, float w0, float w1, float w2, float bias, float (&o0)[8], float (&o1)[8]) {
    ((HLAS u32x4s*)stg)[tid] = rp.a;
    ((HLAS u32x4s*)stg)[512 + tid] = rp.b;
    __syncthreads();
#pragma unroll
    for (int q = 0; q < 8; ++q) { const int l = tid + 512 * q;
        const int lm = l > 0 ? l - 1 : 0, lp = l < L - 1 ? l + 1 : L - 1;
        const float wm = l > 0 ? w0 : 0.f, wp = l < L - 1 ? w2 : 0.f;
        o0[q] = bf2f(stg[l]) * w1 + bias + bf2f(stg[lm]) * wm + bf2f(stg[lp]) * wp;
        o1[q] = bf2f(stg[4096 + l]) * w1 + bias + bf2f(stg[4096 + lm]) * wm + bf2f(stg[4096 + lp]) * wp; }
}
__device__ __forceinline__ void hyena_channel(const P& p, int c, HLAS unsigned char* lds, int tid_) {
    int tid = opq(tid_);
    HLAS f32x2* buf = (HLAS f32x2*)(lds + OFF_BUF); HLAS f32x2* H1 = (HLAS f32x2*)(lds + OFF_H1); HLAS f32x2* H2 = (HLAS f32x2*)(lds + OFF_H2);
    const float* hid3 = (const float*)(p.ws + WS_HID3);
    const bf16* hyT = (const bf16*)(p.ws + WS_HYT); bf16* hyo = (bf16*)(p.ws + WS_HYT2);
    __syncthreads();
    {
        const float* ft = (const float*)(p.ws + WS_FILT) + (size_t)c * L;
#pragma unroll
        for (int q = 0; q < 8; ++q) { const int l = tid + 512 * q;
            const float f0 = __builtin_nontemporal_load(ft + l), f1 = __builtin_nontemporal_load(ft + (size_t)512 * L + l), f2 = __builtin_nontemporal_load(ft + (size_t)1024 * L + l), f3 = __builtin_nontemporal_load(ft + (size_t)1536 * L + l);
            buf[phys(l)] = (f32x2){f0, f2};
            if (l >= 1) buf[phys(N - l)] = (f32x2){f1, f3}; }
        if (tid == 0) buf[phys(4096)] = (f32x2){0.f, 0.f};
    }
    RowPair rz = rows_load(hyT + ((size_t)0 * HYC + c) * L, hyT + ((size_t)1 * HYC + c) * L, tid);
    __syncthreads();
    fft_lds(buf, tid_);
    tid = opq(tid_);
#pragma unroll
    for (int q = 0; q < 8; ++q) { const int k = tid + 512 * q; const f32x2 wk = buf[phys(k)], wn = buf[phys((N - k) & (N - 1))];
        const float s = 0.5f / (float)N;
        H1[k] = (f32x2){(wk.x + wn.x) * s, (wk.y - wn.y) * s};
        H2[k] = (f32x2){(wk.y + wn.y) * s, (wn.x - wk.x) * s}; }
    if (tid == 0) { const f32x2 wk = buf[phys(4096)]; H1[4096] = (f32x2){wk.x / (float)N, 0.f}; H2[4096] = (f32x2){wk.y / (float)N, 0.f}; }
    const float w0z = p.scw[c], w1z = p.scw[HYC + c], w2z = p.scw[2 * HYC + c], bz = p.scb[c];
    const float w0a = p.scw[512 + c], w1a = p.scw[HYC + 512 + c], w2a = p.scw[2 * HYC + 512 + c], ba = p.scb[512 + c];
    const float w0b = p.scw[1024 + c], w1b = p.scw[HYC + 1024 + c], w2b = p.scw[2 * HYC + 1024 + c], bb = p.scb[1024 + c];
    const float sk1 = p.hskip[c], sk2 = p.hskip[512 + c];
#pragma unroll 1
    for (int pp = 0; pp < 2; ++pp) {
        const int b0 = 2 * pp, b1 = 2 * pp + 1;
        const bf16* z0p = hyT + ((size_t)b0 * HYC + c) * L; const bf16* z1p = hyT + ((size_t)b1 * HYC + c) * L;
        float zr[8], zi[8], yr[8], yi[8], gr[8], gi[8];
        HLAS unsigned short* stg = (HLAS unsigned short*)(lds + OFF_BUF);
        tid = opq(tid_);
        __syncthreads();
        sconv_pair(rz, stg, tid, w0z, w1z, w2z, bz, zr, zi);
        RowPair rg = rows_load(z0p + (size_t)512 * L, z1p + (size_t)512 * L, tid);
        conv_apply(buf, H1, tid_, zr, zi, yr, yi);
        tid = opq(tid_);
        __syncthreads();
        sconv_pair(rg, stg, tid, w0a, w1a, w2a, ba, gr, gi);
#pragma unroll
        for (int q = 0; q < 8; ++q) { zr[q] = gr[q] * (yr[q] + sk1 * zr[q]); zi[q] = gi[q] * (yi[q] + sk1 * zi[q]); }
        rg = rows_load(z0p + (size_t)1024 * L, z1p + (size_t)1024 * L, tid);
        { const int nb = (pp == 0) ? 2 : 0; rz = rows_load(hyT + ((size_t)nb * HYC + c) * L, hyT + ((size_t)(nb + 1) * HYC + c) * L, tid); }
        conv_apply(buf, H2, tid_, zr, zi, yr, yi);
        tid = opq(tid_);
        __syncthreads();
        sconv_pair(rg, stg, tid, w0b, w1b, w2b, bb, gr, gi);
#pragma unroll
        for (int q = 0; q < 8; ++q) { const int l = tid + 512 * q;
            hyo[((size_t)b0 * HW + c) * L + l] = (bf16)f2bf(gr[q] * (yr[q] + sk2 * zr[q])); hyo[((size_t)b1 * HW + c) * L + l] = (bf16)f2bf(gi[q] * (yi[q] + sk2 * zi[q])); }
    }
    __syncthreads();
}
#undef HLAS
}
#define LAS __attribute__((address_space(3)))
constexpr int NWAVES = 8, NTHR = 512;
constexpr int RING_BYTES = 131072, LDS_BYTES = 147456;
#define LDS_WAIT() asm volatile("s_waitcnt lgkmcnt(0)" ::: "memory")
constexpr int MISC_OFF = LDS_BYTES - 256;
constexpr int CW_BAR = 4096;
#define GAS __attribute__((address_space(1)))
typedef unsigned v4u __attribute__((ext_vector_type(4)));
typedef GAS unsigned gu32;
typedef GAS unsigned long long gu64;
#define RLX_AGENT __ATOMIC_RELAXED, __HIP_MEMORY_SCOPE_AGENT
#define VM_WAIT() asm volatile("s_waitcnt vmcnt(0)" ::: "memory")
__device__ __forceinline__ unsigned long long rt() { return __builtin_amdgcn_s_memrealtime(); }

#define XB_TMO      128
#define XB_XCNT(j)  (256  + 64 * (j))
#define XB_XSUB(j)  (1280 + 64 * (j))
#define XB_XGEN(j)  (2304 + 64 * (j))
#define XB_TOP      3328
#define XB_TOPGEN   3392
#define XCD_BAR_WORDS 3456
#define XB_SPIN_CAP (1u << 18)

__device__ __forceinline__ unsigned xb_ld(unsigned* p)              { return __hip_atomic_load(p, __ATOMIC_RELAXED, __HIP_MEMORY_SCOPE_AGENT); }
__device__ __forceinline__ unsigned xb_add(unsigned* p, unsigned v) { return __hip_atomic_fetch_add(p, v, __ATOMIC_RELAXED, __HIP_MEMORY_SCOPE_AGENT); }
__device__ __forceinline__ unsigned xb_xcc_id() { return (unsigned)__builtin_amdgcn_s_getreg((3 << 11) | 20) & 0xFu; }
#define XB_SPIN(cond, bar) do { unsigned _sp = 0; while (cond) { __builtin_amdgcn_s_sleep(1); \
    if ((++_sp & 255u) == 0u) { if (xb_ld(&(bar)[XB_TMO])) break; if (_sp > XB_SPIN_CAP) { atomicAdd(&(bar)[XB_TMO], 1u); break; } } } } while (0)

struct XcdBarrier {
    unsigned* bar; unsigned x;
    volatile LAS unsigned* st;
};

__device__ __forceinline__ XcdBarrier xcd_barrier_post(unsigned* bar, volatile LAS unsigned* st) {
    XcdBarrier b; b.bar = bar; b.x = xb_xcc_id(); b.st = st;
    if (threadIdx.x == 0) (void)xb_add(&bar[XB_XCNT(b.x)], 1u);
    return b;
}
__device__ __forceinline__ void xcd_barrier_complete(unsigned* bar, unsigned x, unsigned& nloc, unsigned& nx) {
    const unsigned G = gridDim.x * gridDim.y * gridDim.z;
    unsigned sum, cnt, mine, sp = 0u;
    for (;;) {
        sum = 0u; cnt = 0u; mine = 0u;
#pragma unroll
        for (unsigned j = 0; j < 16; ++j) { const unsigned c = xb_ld(&bar[XB_XCNT(j)]); sum += c; cnt += (c > 0u) ? 1u : 0u; mine = (j == x) ? c : mine; }
        if (sum == G) break;
        __builtin_amdgcn_s_sleep(1);
        if ((++sp & 255u) == 0u) { if (xb_ld(&bar[XB_TMO])) break; if (sp > XB_SPIN_CAP) { atomicAdd(&bar[XB_TMO], 1u); break; } }
    }
    nloc = mine > 0u ? mine : 1u; nx = cnt > 0u ? cnt : 1u;
}

__device__ __forceinline__ void xcd_barrier(const XcdBarrier& b) {
    asm volatile("s_waitcnt vmcnt(0)" ::: "memory");
    __syncthreads();
    if (threadIdx.x == 0) {
        unsigned* bar = b.bar;
        __builtin_amdgcn_s_waitcnt(0);
        unsigned nloc = b.st[0], nx = b.st[1];
        if (nloc == 0u) { xcd_barrier_complete(bar, b.x, nloc, nx); b.st[0] = nloc; b.st[1] = nx; }
        const unsigned old = xb_add(&bar[XB_XSUB(b.x)], 1u);
        const unsigned gen = old / nloc;
        if (old + 1u == (gen + 1u) * nloc) {
            __builtin_amdgcn_fence(__ATOMIC_RELEASE, "agent");
            asm volatile("s_waitcnt vmcnt(0)" ::: "memory");
            const unsigned og = xb_add(&bar[XB_TOP], 1u);
            const unsigned tg = og / nx;
            if (og + 1u == (tg + 1u) * nx) xb_add(&bar[XB_TOPGEN], 1u);
            else XB_SPIN(xb_ld(&bar[XB_TOPGEN]) == tg, bar);
            __builtin_amdgcn_fence(__ATOMIC_ACQUIRE, "agent");
            xb_add(&bar[XB_XGEN(b.x)], 1u);
            asm volatile("s_waitcnt vmcnt(0)" ::: "memory");
        } else {
            XB_SPIN(xb_ld(&bar[XB_XGEN(b.x)]) == gen, bar);
            __builtin_amdgcn_fence(__ATOMIC_ACQUIRE, "agent");
            asm volatile("s_waitcnt vmcnt(0)" ::: "memory");
        }
    }
    __syncthreads();
}

__device__ __forceinline__ int colmap_in(int R) {
    if (R >= 3584) return 1536 + (R - 3584);
    const int pn = R >> 8, rt = R & 255;
    if (pn < 4) { const int bj = rt >> 7, wc = (rt >> 5) & 3, i = rt & 31, gidx = pn * 4 + wc;
        const int d = (bj == 0 && i < 16) ? (4 * (i >> 3) + ((i & 7) >> 1) + 8 * (i & 1)) : (32 * bj + i);
        return gidx * 64 + d; }
    if (pn < 6) return 1024 + (pn - 4) * 256 + rt;
    return 3072 + (pn - 6) * 256 + rt;
}
__device__ __forceinline__ void transpose_item(const float* W, int N, int K, bf16* WT, int k0, int drow0, int scol, const float* kscale, LAS float* scr, int lane) {
#pragma unroll 16
    for (int i = 0; i < 32; ++i) { const int kk = 2 * i + (lane >> 5); scr[kk * 33 + (lane & 31)] = __builtin_nontemporal_load(W + (size_t)(k0 + kk) * N + scol); }
    const int c = lane & 7;
    pg8::f32x4 ks0 = {1.f, 1.f, 1.f, 1.f}, ks1 = {1.f, 1.f, 1.f, 1.f};
    if (kscale) { ks0 = *(const pg8::f32x4*)(kscale + k0 + 8 * c); ks1 = *(const pg8::f32x4*)(kscale + k0 + 8 * c + 4); }
    LDS_WAIT(); asm volatile("" ::: "memory");
#pragma unroll
    for (int j = 0; j < 4; ++j) { const int n = (lane >> 3) + 8 * j; const LAS float* s = scr + (8 * c) * 33 + n;
        uint4 o; o.x = pk2(s[0 * 33] * ks0[0], s[1 * 33] * ks0[1]); o.y = pk2(s[2 * 33] * ks0[2], s[3 * 33] * ks0[3]); o.z = pk2(s[4 * 33] * ks1[0], s[5 * 33] * ks1[1]); o.w = pk2(s[6 * 33] * ks1[2], s[7 * 33] * ks1[3]);
        *(uint4*)(WT + (size_t)(drow0 + n) * K + k0 + 8 * c) = o; }
    LDS_WAIT(); asm volatile("" ::: "memory");
}
__device__ __forceinline__ void transpose_item_fp8(const float* W, int N, int K, unsigned char* WT, int k0, int drow0, int scol, float mul, LAS float* scr, int lane) {
#pragma unroll
    for (int i = 0; i < 32; ++i) { const int kk = 2 * i + (lane >> 5); scr[kk * 33 + (lane & 31)] = __builtin_nontemporal_load(W + (size_t)(k0 + kk) * N + scol) * mul; }
    LDS_WAIT(); asm volatile("" ::: "memory");
    const int c = lane & 7;
#pragma unroll
    for (int j = 0; j < 4; ++j) { const int n = (lane >> 3) + 8 * j; const LAS float* s = scr + (8 * c) * 33 + n;
        uint2 o; o.x = pk4_fp8(s[0 * 33], s[1 * 33], s[2 * 33], s[3 * 33]); o.y = pk4_fp8(s[4 * 33], s[5 * 33], s[6 * 33], s[7 * 33]);
        *(uint2*)(WT + (size_t)(drow0 + n) * K + k0 + 8 * c) = o; }
    LDS_WAIT(); asm volatile("" ::: "memory");
}
__device__ __forceinline__ void p0_prologue(const P& p, LAS unsigned char* lds, int gw, int NGW, int wave, int lane, int gt, int NGT, int mask) {
    LAS float* scr = (LAS float*)(lds + wave * 16384);
    unsigned char* ws = p.ws;
    constexpr int I_IN = 16 * 160, I_PA = 8 * 32, I_O = 16 * 32, NITEMS = I_IN + 2 * I_PA + I_O;
    if (mask & 1)
    for (int it = gw; it < NITEMS; it += NGW) {
        int r = it;
        if (r < I_IN) { const int kb = r / 160, nb = r % 160; transpose_item(p.w_in, INC, D, (bf16*)(ws + WS_WINT), kb * 64, nb * 32, colmap_in(nb * 32 + (lane & 31)), p.norm1_g, scr, lane); continue; } r -= I_IN;
        if (r < I_PA) { const int kb = r / 32, nb = r % 32; transpose_item(p.wpa, D, 512, (bf16*)(ws + WS_WPA), kb * 64, nb * 32, nb * 32 + (lane & 31), nullptr, scr, lane); continue; } r -= I_PA;
        if (r < I_PA) { const int kb = r / 32, nb = r % 32; transpose_item(p.wph, D, 512, (bf16*)(ws + WS_WPH), kb * 64, nb * 32, nb * 32 + (lane & 31), nullptr, scr, lane); continue; } r -= I_PA;
        { const int kb = r / 32, nb = r % 32; transpose_item(p.wo, D, D, (bf16*)(ws + WS_WO), kb * 64, nb * 32, nb * 32 + (lane & 31), nullptr, scr, lane); }
    }
    float* rstd1 = (float*)(ws + WS_RSTD1); bf16* xb = (bf16*)(ws + WS_XB);
    if (mask & 2)
    for (int t0 = gw * 4; t0 < T; t0 += NGW * 4) {
        float4 v[4][4];
#pragma unroll
        for (int r = 0; r < 4; ++r)
#pragma unroll
            for (int j = 0; j < 4; ++j) { const pg8::f32x4 t_ = __builtin_nontemporal_load((const pg8::f32x4*)(p.x + (size_t)(t0 + r) * D) + lane + 64 * j); v[r][j] = make_float4(t_[0], t_[1], t_[2], t_[3]); }
#pragma unroll
        for (int r = 0; r < 4; ++r) { float s = 0.f;
#pragma unroll
            for (int j = 0; j < 4; ++j) { const float4 q = v[r][j]; s += q.x * q.x + q.y * q.y + q.z * q.z + q.w * q.w;
                uint2 pk; pk.x = pk2(q.x, q.y); pk.y = pk2(q.z, q.w); ((uint2*)(xb + (size_t)(t0 + r) * D))[lane + 64 * j] = pk; }
            s = wave_sum(s);
            if (lane == 0) rstd1[t0 + r] = 1.0f / sqrtf(s * (1.0f / D) + EPS); }
    }
    float* rc = (float*)(ws + WS_ROPE); float* rs = rc + L * 8;
    if (mask & 4) {
        constexpr double INVF[8] = {1.0, 0.19392274474868576, 0.03760603093086393, 0.007292664737217109, 0.001414213562373095, 0.0002742481756762073, 5.318295896944988e-05, 1.031338537721246e-05};
        if ((gt & 3) == 0 && (gt >> 2) < L * 8) { const int i = gt >> 2, l = i >> 3, j = i & 7;
            double invf = INVF[0];
#pragma unroll
            for (int q = 1; q < 8; ++q) invf = (j == q) ? INVF[q] : invf;
            const double ang = (double)l * invf, rr = ang - 6.283185307179586476925 * rint(ang * 0.15915494309189533577);
            const float rf = (float)rr;
            rc[i] = cosf(rf); rs[i] = sinf(rf); }
    }
    float* hid3 = (float*)(ws + WS_HID3);
    if (mask & 8)
    for (int l = gw; l < L; l += NGW) {
        const float t = (float)l / (float)(L - 1);
        const float fr = p.ffreq[lane];
        float a = p.fb1[lane] + t * p.fw1[lane];
        for (int j = 0; j < 16; ++j) {
            const float band = 1e-4f + (float)j * ((15.0f - 1e-4f) / 15.0f);
            const float ang = (2.0f * 3.14159265358979323846f / (float)L) * (float)l * band;
            a += cosf(ang) * p.fw1[(1 + j) * 64 + lane] - sinf(ang) * p.fw1[(17 + j) * 64 + lane];
        }
        float h = sinf(fr * a);
        float a2 = p.fb2[lane];
        for (int i = 0; i < 64; ++i) a2 += __shfl(h, i) * p.fw2[i * 64 + lane];
        h = sinf(fr * a2);
        float a3 = p.fb3[lane];
        for (int i = 0; i < 64; ++i) a3 += __shfl(h, i) * p.fw3[i * 64 + lane];
        hid3[(size_t)lane * L + l] = sinf(fr * a3);
    }
}

__device__ __forceinline__ void p1_filter_taps(const P& p, int gw, int NGW, int lane) {
    typedef float f32x16 __attribute__((ext_vector_type(16)));
    const float* hid3 = (const float*)(p.ws + WS_HID3); float* ft = (float*)(p.ws + WS_FILT);
    const float mind = logf(1e-2f) / 1.5f, maxd = logf(1e-2f) / 0.3f;
    const int r32 = lane & 31, hi = lane >> 5;
    for (int task = gw; task < 128 * 16; task += NGW) {
        const int l0 = (task & 127) * 32, cg = task >> 7, l = l0 + r32;
        float bv[32], av[32], an[32];
#pragma unroll
        for (int s2 = 0; s2 < 32; ++s2) bv[s2] = hid3[(size_t)(2 * s2 + hi) * L + l];
#pragma unroll
        for (int s2 = 0; s2 < 32; ++s2) av[s2] = p.fwo[(size_t)(2 * s2 + hi) * 2048 + cg * 128 + r32];
        const float tl2 = ((float)l / (float)(L - 1)) * 1.4426950408889634f;
#pragma unroll
        for (int ct = 0; ct < 4; ++ct) {
            const int col0 = cg * 128 + ct * 32;
            if (ct < 3) {
#pragma unroll
                for (int s2 = 0; s2 < 32; ++s2) an[s2] = p.fwo[(size_t)(2 * s2 + hi) * 2048 + col0 + 32 + r32];
            }
            f32x16 acc = f32x16{};
#pragma unroll
            for (int s2 = 0; s2 < 32; ++s2) acc = __builtin_amdgcn_mfma_f32_32x32x2f32(av[s2], bv[s2], acc, 0, 0, 0);
#pragma unroll
            for (int r = 0; r < 16; ++r) { const int col = col0 + (r & 3) + 8 * (r >> 2) + 4 * hi;
                const float delta = fabsf(mind + (maxd - mind) * (float)(col & 511) / 511.0f);
                ft[(size_t)col * L + l] = acc[r] * __builtin_amdgcn_exp2f(-tl2 * delta); }
            if (ct < 3) {
#pragma unroll
                for (int s2 = 0; s2 < 32; ++s2) av[s2] = an[s2];
            }
        }
    }
}

__device__ __forceinline__ void p3_transpose_panel(const P& p, LAS unsigned char* lds, int pm, int wave, int lane) {
    typedef short v4i16_t __attribute__((ext_vector_type(4)));
    const int t0 = pm * 256, b = t0 / L, l0 = t0 % L;
    const bf16* src = (const bf16*)(p.ws + WS_HYT2) + ((size_t)b * HW) * L + l0; bf16* dst = (bf16*)(p.ws + WS_HYENA) + (size_t)t0 * HW;
    LAS unsigned char* img = lds + wave * 9216;
    const int g = lane >> 4, i = lane & 15, q = i >> 2, pq = i & 3;
    for (int tile = wave * 4; tile < wave * 4 + 4; ++tile) {
        const int c0 = (tile >> 2) * 64, k0 = (tile & 3) * 64;
        pg8::u32x4 v[8];
#pragma unroll
        for (int j = 0; j < 8; ++j) v[j] = *(const pg8::u32x4*)(src + (size_t)(c0 + (lane >> 3) + 8 * j) * L + k0 + (lane & 7) * 8);
#pragma unroll
        for (int j = 0; j < 8; ++j) *(LAS pg8::u32x4*)(img + ((lane >> 3) + 8 * j) * 144 + (lane & 7) * 16) = v[j];
        LDS_WAIT(); asm volatile("" ::: "memory");
#pragma unroll
        for (int k = 0; k < 8; ++k) {
            const int ch = 8 * (4 * (k & 1) + g), tk = 16 * (k >> 1);
            const LAS unsigned char* a0 = img + (ch + q) * 144 + (tk + 4 * pq) * 2;
            const v4i16_t lo = __builtin_amdgcn_ds_read_tr16_b64_v4i16((LAS v4i16_t*)a0), hi = __builtin_amdgcn_ds_read_tr16_b64_v4i16((LAS v4i16_t*)(a0 + 4 * 144));
            pg8::u32x4 o; o.x = (unsigned short)lo[0] | ((unsigned)(unsigned short)lo[1] << 16); o.y = (unsigned short)lo[2] | ((unsigned)(unsigned short)lo[3] << 16);
            o.z = (unsigned short)hi[0] | ((unsigned)(unsigned short)hi[1] << 16); o.w = (unsigned short)hi[2] | ((unsigned)(unsigned short)hi[3] << 16);
            *(pg8::u32x4*)(dst + (size_t)(k0 + tk + i) * HW + c0 + ch) = o;
        }
        LDS_WAIT(); asm volatile("" ::: "memory");
    }
    asm volatile("s_waitcnt vmcnt(0)" ::: "memory");
    __syncthreads();
}

__device__ __forceinline__ void p5_router(const P& p, LAS unsigned char* lds, int gw, int NGW, int tid, int lane) {
    LAS float* wrT = (LAS float*)lds;
    float* aff = (float*)(p.ws + WS_AFF); unsigned char* u2 = (unsigned char*)(p.ws + WS_U2);
    constexpr int RPW = 8;
    pg8::f32x4 rows[RPW][4];
#pragma unroll
    for (int i = 0; i < RPW; ++i)
#pragma unroll
        for (int j = 0; j < 4; ++j) rows[i][j] = ((const pg8::f32x4*)(p.out + (size_t)(gw + i * NGW) * D))[lane + 64 * j];
    for (int i = tid; i < D * NE; i += NTHR) { const int d = i >> 4, e = i & 15; wrT[e * D + d] = p.wr[i]; }
    pg8::f32x4 g4[4];
#pragma unroll
    for (int j = 0; j < 4; ++j) g4[j] = ((const pg8::f32x4*)p.norm2_g)[lane + 64 * j];
    __syncthreads();
#pragma unroll
    for (int i = 0; i < RPW; ++i) {
        const int t = gw + i * NGW;
        pg8::f32x4 u[4]; float s = 0.f;
#pragma unroll
        for (int j = 0; j < 4; ++j) { u[j] = rows[i][j]; s += u[j][0] * u[j][0] + u[j][1] * u[j][1] + u[j][2] * u[j][2] + u[j][3] * u[j][3]; }
        const float r = 1.0f / sqrtf(wave_sum(s) * (1.0f / D) + EPS);
#pragma unroll
        for (int j = 0; j < 4; ++j) {
            u[j] = u[j] * g4[j] * r;
            ((unsigned*)(u2 + (size_t)t * D))[lane + 64 * j] = pk4_fp8(u[j][0], u[j][1], u[j][2], u[j][3]);
        }
        float pa[NE];
#pragma unroll
        for (int e = 0; e < NE; ++e) {
            float a = 0.f;
#pragma unroll
            for (int j = 0; j < 4; ++j) { const pg8::f32x4 w = ((const LAS pg8::f32x4*)(wrT + e * D))[lane + 64 * j]; a += u[j][0] * w[0] + u[j][1] * w[1] + u[j][2] * w[2] + u[j][3] * w[3]; }
            pa[e] = a;
            asm volatile("" : "+v"(pa[e]));
        }
        float r8[8], r4[4], r2[2], r1;
#pragma unroll
        for (int e = 0; e < 8; ++e) { const bool up = (lane & 32) != 0; const float keep = up ? pa[e + 8] : pa[e], give = up ? pa[e] : pa[e + 8]; r8[e] = keep + __shfl_xor(give, 32); }
#pragma unroll
        for (int e = 0; e < 4; ++e) { const bool up = (lane & 16) != 0; const float keep = up ? r8[e + 4] : r8[e], give = up ? r8[e] : r8[e + 4]; r4[e] = keep + __shfl_xor(give, 16); }
#pragma unroll
        for (int e = 0; e < 2; ++e) { const bool up = (lane & 8) != 0; const float keep = up ? r4[e + 2] : r4[e], give = up ? r4[e] : r4[e + 2]; r2[e] = keep + __shfl_xor(give, 8); }
        { const bool up = (lane & 4) != 0; const float keep = up ? r2[1] : r2[0], give = up ? r2[0] : r2[1]; r1 = keep + __shfl_xor(give, 4); }
        r1 += __shfl_xor(r1, 2); r1 += __shfl_xor(r1, 1);
        const int eidx = ((lane >> 5) & 1) * 8 + ((lane >> 4) & 1) * 4 + ((lane >> 3) & 1) * 2 + ((lane >> 2) & 1);
        float mx = r1;
#pragma unroll
        for (int o = 4; o < 64; o <<= 1) mx = fmaxf(mx, __shfl_xor(mx, o));
        const float exv = expf(r1 - mx);
        float se = exv;
#pragma unroll
        for (int o = 4; o < 64; o <<= 1) se += __shfl_xor(se, o);
        { const int b = t / L, l = t % L; if ((lane & 3) == 0) aff[((size_t)b * NE + eidx) * L + l] = exv / se; }
    }
    __syncthreads();
}

__device__ __forceinline__ void p6_topk_group(const P& p, LAS unsigned char* lds, int g, int tid, int lane, int wid) {
    LAS unsigned* cnt = (LAS unsigned*)lds; LAS unsigned* wsum = cnt + 8;
    const float* aff = (const float*)(p.ws + WS_AFF) + (size_t)g * L;
    unsigned v[8];
#pragma unroll
    for (int i = 0; i < 8; ++i) v[i] = __builtin_bit_cast(unsigned, aff[tid * 8 + i]);
    unsigned prefix = 0;
    for (int bit = 31; bit >= 0; --bit) {
        const unsigned cand = prefix | (1u << bit);
        unsigned c = 0;
#pragma unroll
        for (int i = 0; i < 8; ++i) c += (unsigned)__builtin_popcountll(__ballot(v[i] >= cand));
        if (lane == 0) cnt[wid] = c;
        __syncthreads();
        unsigned tot = 0;
#pragma unroll
        for (int w = 0; w < 8; ++w) tot += cnt[w];
        __syncthreads();
        if (tot >= CAP) prefix = cand;
    }
    unsigned ngt = 0, neq = 0;
#pragma unroll
    for (int i = 0; i < 8; ++i) { ngt += v[i] > prefix; neq += v[i] == prefix; }
    unsigned sg = ngt, se = neq;
#pragma unroll
    for (int o = 1; o < 64; o <<= 1) { const unsigned a = __shfl_up(sg, o), c = __shfl_up(se, o); if (lane >= o) { sg += a; se += c; } }
    if (lane == 63) { cnt[wid] = sg; wsum[wid] = se; }
    __syncthreads();
    unsigned og = 0, oe = 0, totg = 0;
#pragma unroll
    for (int w = 0; w < 8; ++w) { if (w < wid) { og += cnt[w]; oe += wsum[w]; } totg += cnt[w]; }
    unsigned pg = og + sg - ngt, pe = oe + se - neq;
    const unsigned need_eq = CAP - totg;
    int* stok = (int*)(p.ws + WS_SELTOK) + g * CAP; float* sgate = (float*)(p.ws + WS_SELGATE) + g * CAP;
    short* inv = (short*)(p.ws + WS_INV) + ((size_t)(g >> 4) * L + tid * 8) * NE + (g & 15);
#pragma unroll
    for (int i = 0; i < 8; ++i) {
        int slot = -1;
        if (v[i] > prefix) { slot = (int)pg; ++pg; }
        else if (v[i] == prefix) { if (pe < need_eq) slot = (int)(totg + pe); ++pe; }
        if (slot >= 0) { stok[slot] = (g >> 4) * L + tid * 8 + i; sgate[slot] = __builtin_bit_cast(float, v[i]); }
        inv[i * NE] = (short)slot;
    }
    __syncthreads();
}
__device__ __forceinline__ void p6_convert_experts(const P& p, LAS unsigned char* lds, int bx, int wave, int lane) {
    LAS float* scr = (LAS float*)(lds + 16384 + wave * 12288);
    constexpr int PER_E = 16 * 64 + 16 * 32, NIT = NE * PER_E, SHARE_A = 10, SHARE_B = 13;
    int it0, it1;
    if (bx < 64) { it0 = (bx * NWAVES + wave) * SHARE_A; it1 = it0 + SHARE_A; }
    else { it0 = 64 * NWAVES * SHARE_A + ((bx - 64) * NWAVES + wave) * SHARE_B; it1 = it0 + SHARE_B; }
    if (it1 > NIT) it1 = NIT;
    for (int it = it0; it < it1; ++it) {
        const int e = it / PER_E; int r = it % PER_E;
        if (r < 1024) { const int kb = r >> 6, nb = r & 63, rho = nb * 32, bj = (rho >> 7) & 1, f0 = (rho >> 8) * 128 + (rho & 127);
            transpose_item_fp8((bj ? p.wu : p.wg) + (size_t)e * D * EH, EH, D, (unsigned char*)(p.ws + (e < 8 ? WS_WGU0 : WS_WGU1)) + (size_t)(e & 7) * 2048 * D, kb * 64, rho, f0 + (lane & 31), 32.0f, scr, lane); }
        else { r -= 1024; const int kb = r >> 5, nb = r & 31;
            transpose_item_fp8(p.wd + (size_t)e * EH * D, D, EH, (unsigned char*)(p.ws + (e < 8 ? WS_WD0 : WS_WD1)) + (size_t)(e & 7) * D * EH, kb * 64, nb * 32, nb * 32 + (lane & 31), 32.0f, scr, lane); }
    }
}

__device__ __forceinline__ void p9_combine(const P& p, int gw, int NGW, int lane) {
    const short* inv = (const short*)(p.ws + WS_INV); const bf16* slab = (const bf16*)(p.ws + WS_SLAB);
    for (int t0 = gw * 4; t0 < T; t0 += NGW * 4) {
        pg8::f32x4 a[4][4]; int myslot[4];
#pragma unroll
        for (int r = 0; r < 4; ++r) { myslot[r] = (lane < NE) ? (int)inv[(size_t)(t0 + r) * NE + lane] : -1;
            const pg8::f32x4* orow = (const pg8::f32x4*)(p.out + (size_t)(t0 + r) * D) + lane * 4;
#pragma unroll
            for (int j = 0; j < 4; ++j) a[r][j] = __builtin_nontemporal_load(orow + j); }
        const int b = t0 / L;
#pragma unroll
        for (int r = 0; r < 4; ++r) {
            unsigned long long m = __ballot(myslot[r] >= 0);
            while (m) {
                const int e = __builtin_ctzll(m); m &= m - 1;
                const int slot = __shfl(myslot[r], e);
                const pg8::u32x4* sr = (const pg8::u32x4*)(slab + ((size_t)(b * NE + e) * CAP + slot) * D) + lane * 2;
                const pg8::u32x4 s0 = __builtin_nontemporal_load(sr), s1 = __builtin_nontemporal_load(sr + 1);
                a[r][0] += (pg8::f32x4){bflo(s0[0]), bfhi(s0[0]), bflo(s0[1]), bfhi(s0[1])}; a[r][1] += (pg8::f32x4){bflo(s0[2]), bfhi(s0[2]), bflo(s0[3]), bfhi(s0[3])};
                a[r][2] += (pg8::f32x4){bflo(s1[0]), bfhi(s1[0]), bflo(s1[1]), bfhi(s1[1])}; a[r][3] += (pg8::f32x4){bflo(s1[2]), bfhi(s1[2]), bflo(s1[3]), bfhi(s1[3])};
            }
            pg8::f32x4* orow = (pg8::f32x4*)(p.out + (size_t)(t0 + r) * D) + lane * 4;
#pragma unroll
            for (int j = 0; j < 4; ++j) orow[j] = a[r][j];
        }
    }
}

__global__ void __launch_bounds__(NTHR, 2) mega(P p) {
    extern __shared__ __attribute__((aligned(16))) unsigned char lds_raw[];
    LAS unsigned char* lds = (LAS unsigned char*)lds_raw;
    const int tid = threadIdx.x, lane = tid & 63, wave = __builtin_amdgcn_readfirstlane(tid >> 6);
    const int G = gridDim.x, bx = blockIdx.x;
    const int vcu = (G % 8 == 0) ? (bx % 8) * (G / 8) + bx / 8 : bx;
    const int gw = vcu * NWAVES + wave, NGW = G * NWAVES, gt = bx * NTHR + tid, NGT = G * NTHR;
    unsigned char* ws = p.ws;
    if (tid < 64) ((LAS unsigned*)(lds + MISC_OFF))[tid] = 0u;
    __syncthreads();
    XcdBarrier xbar = xcd_barrier_post((unsigned*)(ws + WS_CTL) + CW_BAR, (volatile LAS unsigned*)(lds + MISC_OFF));
#define IN(k) (p.ph_lo <= (k) && (k) < p.ph_hi)
#if USE_XCD_BAR
#define SEAM(k) do { if (IN(k) && IN((k) + 1)) { if ((k) == CG_SEAM) cooperative_groups::this_grid().sync(); else xcd_barrier(xbar); } } while (0)
#else
#define SEAM(k) do { if (IN(k) && IN((k) + 1)) { cooperative_groups::this_grid().sync(); } } while (0)
#endif
    if (IN(0)) p0_prologue(p, lds, gw, NGW, wave, lane, gt, NGT, 15);
#if PROBE_SUB
    if (IN(10)) p0_prologue(p, lds, gw, NGW, wave, lane, gt, NGT, PROBE_SUB);
#endif
    SEAM(0);
    if (IN(1)) {
        pg8::Gemm g{(const bf16*)(ws + WS_XB), (const bf16*)(ws + WS_WINT), (const bf16*)(ws + WS_WINT) + (size_t)3584 * D, (const bf16*)(ws + WS_XB), D};
        pg8::SchedP1 S{G, bx};
        pg8::EpiInProj E{(const float*)(ws + WS_RSTD1), (const float*)(ws + WS_ROPE), p.qng, p.kng, (bf16*)(ws + WS_QN), (bf16*)(ws + WS_KN), (bf16*)(ws + WS_V), (bf16*)(ws + WS_HYT), (bf16*)(ws + WS_GATES)};
        pg8::gemm_phase<pg8::EpiInProj, pg8::SchedP1, true, true>(lds, g, S, E);
        p1_filter_taps(p, gw, NGW, opq_i(tid) & 63);
    }
    SEAM(1);
    if (IN(2)) {
        int m2i, lami;
        { const float m2v = static_max_log2(p), lamv = calc_lam(p); asm volatile("v_readfirstlane_b32 %0, %2\n\tv_readfirstlane_b32 %1, %3" : "=s"(m2i), "=s"(lami) : "v"(m2v), "v"(lamv)); }
        const float M2 = __builtin_bit_cast(float, m2i), lam = __builtin_bit_cast(float, lami);
        for (int rep = 0; rep < PROBE_ATT; ++rep)
        for (int uid = vcu; uid < 256; uid += G) { const int bh = uid >> 4, qb = uid & 15;
            attn::attn_unit(bh >> 2, bh & 3, qb, (const bf16*)(ws + WS_QN), (const bf16*)(ws + WS_KN), (const bf16*)(ws + WS_V), (bf16*)(ws + WS_ATTN), p.subln, M2, lam, lds, attn::WConv{p.wg, p.wu, p.wd, ws, uid}); }
#if FAST_LEVEL >= 5
        for (int rep = 0; rep < PROBE_HY; ++rep)
#pragma unroll 1
        for (int c = vcu; c < HW; c += G) hy::hyena_channel(p, c, lds, tid);
#endif
    }
    SEAM(2);
    if (IN(3)) {
        pg8::Gemm g{(const bf16*)(ws + WS_ATTN), (const bf16*)(ws + WS_WPA), (const bf16*)(ws + WS_HYENA), (const bf16*)(ws + WS_WPH), 512};
        pg8::SchedP3 S; S.so.init(T, D, G, bx);
        { pg8::Unit u0; S.so.next(0, u0); p3_transpose_panel(p, lds, u0.pm, wave, opq_i(tid) & 63); }
        pg8::EpiMerge E{(const bf16*)(ws + WS_GATES), (bf16*)(ws + WS_TMPM), (bf16*)(ws + WS_MERGED)};
        pg8::gemm_phase<pg8::EpiMerge, pg8::SchedP3, true, true>(lds, g, S, E);
    }
    SEAM(3);
    if (IN(4)) {
        pg8::Gemm g{(const bf16*)(ws + WS_MERGED), (const bf16*)(ws + WS_WO), nullptr, nullptr, D};
        pg8::StaticOrder S; S.init(T, D, G, bx);
        pg8::EpiOutProj E{p.x, p.out};
        pg8::gemm_phase<pg8::EpiOutProj, pg8::StaticOrder, true, true>(lds, g, S, E);
    }
    SEAM(4);
    if (IN(5)) p5_router(p, lds, gw, NGW, tid, opq_i(tid) & 63);
    SEAM(5);
    if (IN(6)) {
        const int lane6 = opq_i(tid) & 63;
        if (bx < 64) p6_topk_group(p, lds, bx, tid, lane6, wave);
#if PROBE_SUB == 77
        p6_convert_experts(p, lds, bx, wave, lane6);
#endif
    }
    SEAM(6);
    if (IN(7)) {
        pg8::Gemm g{(const bf16*)(ws + WS_U2), (const bf16*)(ws + WS_WGU0), (const bf16*)(ws + WS_U2), (const bf16*)(ws + WS_WGU1 - 16 * MiB), D};
        pg8::SchedP7 S{G, bx};
        pg8::EpiGateUp E{(unsigned char*)(ws + WS_HBUF)};
        pg8::gemm_phase<pg8::EpiGateUp, pg8::SchedP7, true, true, true, true, 122, 127>(lds, g, S, E, (const int*)(ws + WS_SELTOK));
    }
    SEAM(7);
    if (IN(8)) {
        pg8::Gemm g{(const bf16*)(ws + WS_HBUF), (const bf16*)(ws + WS_WD0), (const bf16*)(ws + WS_HBUF), (const bf16*)(ws + WS_WD1 - 8 * MiB), EH};
        pg8::SchedP8 S{G, bx};
        pg8::EpiDown E{(const float*)(ws + WS_SELGATE), (bf16*)(ws + WS_SLAB)};
        pg8::gemm_phase<pg8::EpiDown, pg8::SchedP8, true, true, false, true, 122, 127>(lds, g, S, E);
    }
    SEAM(8);
    if (IN(9)) p9_combine(p, gw, NGW, opq_i(tid) & 63);
#undef IN
}

extern "C" void kernel_launch(void* const* d_in, const int* in_sizes, int n_in, void* d_out, int out_size, void* d_ws, size_t ws_size, hipStream_t stream) {
    static int ok = 0;
    if (ok == 0) {
        if (n_in != 29 || ws_size < WS_END) { fprintf(stderr, "kernel_launch: bad args n_in=%d ws=%zu\n", n_in, ws_size); ok = -1; return; }
        if (hipFuncSetAttribute((const void*)mega, hipFuncAttributeMaxDynamicSharedMemorySize, LDS_BYTES) != hipSuccess) { fprintf(stderr, "hipFuncSetAttribute failed\n"); ok = -1; return; }
        int dev = 0, cus = 0, per_cu = 0;
        (void)hipGetDevice(&dev); (void)hipDeviceGetAttribute(&cus, hipDeviceAttributeMultiprocessorCount, dev);
        (void)hipOccupancyMaxActiveBlocksPerMultiprocessor(&per_cu, (const void*)mega, NTHR, LDS_BYTES);
        if (cus * per_cu < 256) { fprintf(stderr, "kernel_launch: the 256-workgroup grid is not co-resident on this device (%d CUs x %d)\n", cus, per_cu); ok = -1; return; }
        ok = 1;
    }
    if (ok < 0) return;
    P p{};
    const float** f = (const float**)&p;
    for (int i = 0; i < 29; ++i) f[i] = (const float*)d_in[i];
    p.out = (float*)d_out; p.ws = (unsigned char*)d_ws;
    (void)hipMemsetAsync((char*)d_ws + WS_CTL, 0, 1 * MiB, stream);
#if ONE_LAUNCH
    p.ph_lo = 0; p.ph_hi = 10;
    { void* args[] = {&p}; hipError_t e = hipLaunchCooperativeKernel((const void*)mega, dim3(256), dim3(NTHR), args, LDS_BYTES, stream);
      if (e != hipSuccess) fprintf(stderr, "cooperative launch failed: %s\n", hipGetErrorString(e)); }
#else
#define MEGA(lo, hi) do { p.ph_lo = (lo); p.ph_hi = (hi); hipLaunchKernelGGL(mega, dim3(256), dim3(NTHR), LDS_BYTES, stream, p); } while (0)
    for (int k = 0; k < 10; ++k) { MEGA(k, k + 1); if (k == PROBE_DBL) MEGA(k, k + 1); }
    if (PROBE_DBL == 99) MEGA(99, 100);
#endif
}
```

```cpp
#include <hip/hip_runtime.h>
#include <hip/hip_cooperative_groups.h>
#include <cstdio>
#include <cstdint>
#include <cmath>

#ifndef ONE_LAUNCH
#define ONE_LAUNCH 1
#endif
#ifndef CG_SEAM
#define CG_SEAM -1
#endif
#ifndef USE_XCD_BAR
#define USE_XCD_BAR 1
#endif
#ifndef PROBE_ATT
#define PROBE_ATT 1
#endif
#ifndef PROBE_HY
#define PROBE_HY 1
#endif
#ifndef PROBE_P0
#define PROBE_P0 1
#endif
#ifndef PROBE_P1
#define PROBE_P1 1
#endif
#ifndef PROBE_P3
#define PROBE_P3 1
#endif
#ifndef PROBE_P4
#define PROBE_P4 1
#endif
#ifndef PROBE_P5
#define PROBE_P5 1
#endif
#ifndef PROBE_P6
#define PROBE_P6 1
#endif
#ifndef PROBE_P7
#define PROBE_P7 1
#endif
#ifndef PROBE_SUB
#define PROBE_SUB 0
#endif
#ifndef PROBE_DBL
#define PROBE_DBL -1
#endif
#ifndef REP_EpiInProj
#define REP_EpiInProj 1
#endif
#ifndef REP_EpiMerge
#define REP_EpiMerge 1
#endif
#ifndef REP_EpiOutProj
#define REP_EpiOutProj 1
#endif
#ifndef REP_EpiGateUp
#define REP_EpiGateUp 1
#endif
#ifndef REP_EpiDown
#define REP_EpiDown 1
#endif
#ifndef RIDE_DMA
#define RIDE_DMA 1
#endif
#ifndef RIDE_CVT
#define RIDE_CVT 1
#endif
#ifndef FAST_LEVEL
#define FAST_LEVEL 5
#endif
constexpr int Bn = 4, L = 4096, D = 1024, T = Bn * L;
constexpr int NH = 4, QK = 64, VD = 128, AW = 512;
constexpr int HW = 512, HYC = 1536, GC = 2048, INC = 5120;
constexpr int NE = 16, CAP = 512, EH = 1024;
constexpr float EPS = 1e-6f;
constexpr float LAMBDA_INIT = 0.2f;
constexpr float QSCALE = 0.125f * 1.4426950408889634f;

typedef unsigned short bf16;
typedef float cvf32x2_t __attribute__((ext_vector_type(2))); typedef __bf16 cvbf16x2_t __attribute__((ext_vector_type(2)));
__device__ __forceinline__ unsigned pk2(float lo, float hi) { const cvf32x2_t v = {lo, hi}; return __builtin_bit_cast(unsigned, __builtin_convertvector(v, cvbf16x2_t)); }
__device__ __forceinline__ unsigned f2bf(float f) { return pk2(f, 0.f) & 0xffffu; }
__device__ __forceinline__ float bf2f(bf16 h) { return __builtin_bit_cast(float, (unsigned)h << 16); }
__device__ __forceinline__ unsigned pk4_fp8(float a, float b, float c, float d) { int w = 0; w = __builtin_amdgcn_cvt_pk_fp8_f32(a, b, w, false); w = __builtin_amdgcn_cvt_pk_fp8_f32(c, d, w, true); return (unsigned)w; }
__device__ __forceinline__ float bflo(unsigned w) { return __builtin_bit_cast(float, w << 16); }
__device__ __forceinline__ float bfhi(unsigned w) { return __builtin_bit_cast(float, w & 0xffff0000u); }

constexpr size_t MiB = 1u << 20;
constexpr size_t WS_CTL = 0;
constexpr size_t WS_RSTD1 = 1 * MiB;
constexpr size_t WS_ROPE = 1 * MiB + 256 * 1024;
constexpr size_t WS_SELTOK = 1 * MiB + 512 * 1024;
constexpr size_t WS_SELGATE = 1 * MiB + 768 * 1024;
constexpr size_t WS_HID3 = 2 * MiB;
constexpr size_t WS_AFF = 3 * MiB;
constexpr size_t WS_WINT = 4 * MiB;
constexpr size_t WS_WPA = 15 * MiB, WS_WPH = 16 * MiB, WS_WO = 17 * MiB;
constexpr size_t WS_XB = 19 * MiB;
constexpr size_t WS_QN = 51 * MiB, WS_KN = 67 * MiB, WS_V = 83 * MiB;
constexpr size_t WS_HYT = 99 * MiB;
constexpr size_t WS_GATES = 147 * MiB;
constexpr size_t WS_ATTN = 211 * MiB, WS_HYENA = 131 * MiB;
constexpr size_t WS_TMPM = 243 * MiB, WS_MERGED = 51 * MiB;
constexpr size_t WS_HYT2 = 19 * MiB;
constexpr size_t WS_U2 = 83 * MiB;
constexpr size_t WS_WGU0 = 35 * MiB, WS_WGU1 = 227 * MiB;
constexpr size_t WS_WD0 = 4 * MiB, WS_WD1 = 275 * MiB;
constexpr size_t WS_HBUF = 99 * MiB;
constexpr size_t WS_INV = 15 * MiB;
constexpr size_t WS_SLAB = 147 * MiB;
constexpr size_t WS_FILT = 243 * MiB;
constexpr size_t WS_RSTD2 = 1 * MiB + 64 * 1024;
constexpr size_t WS_END = 283 * MiB;
constexpr size_t WS_KERNT = 19 * MiB;
constexpr size_t WS_Z0 = 243 * MiB;
constexpr size_t WS_Z1 = 51 * MiB;

struct P {
    const float *x, *norm1_g, *w_in, *scw, *scb, *qng, *kng, *lq1, *lk1, *lq2, *lk2, *subln, *fw1, *fb1, *fw2, *fb2, *fw3, *fb3, *fwo, *ffreq, *hskip, *wpa, *wph, *wo, *norm2_g, *wr, *wg, *wu, *wd;
    float* out; unsigned char* ws;
    int ph_lo, ph_hi;
};

__device__ __forceinline__ int opq_i(int x) { asm volatile("" : "+v"(x)); return x; }
__device__ __forceinline__ float wave_sum(float v) {
#pragma unroll
    for (int o = 1; o < 64; o <<= 1) v += __shfl_xor(v, o);
    return v;
}
__device__ __forceinline__ float static_max_log2(const P& p) {
    float mq = 0.f, mk = 0.f;
    for (int d = 0; d < 64; ++d) { mq = fmaxf(mq, fabsf(p.qng[d])); mk = fmaxf(mk, fabsf(p.kng[d])); }
    return 8.0f * mq * mk * 1.4426950408889634f * 1.01f + 0.05f;
}
__device__ __forceinline__ float calc_lam(const P& p) {
    float a = 0.f, c = 0.f;
    for (int d = 0; d < 64; ++d) { a += p.lq1[d] * p.lk1[d]; c += p.lq2[d] * p.lk2[d]; }
    return expf(a) - expf(c) + LAMBDA_INIT;
}
namespace pg8 {
#define PG8_LAS __attribute__((address_space(3)))
typedef unsigned short bf16_t;
typedef short bf16x8 __attribute__((ext_vector_type(8)));
typedef float f32x4 __attribute__((ext_vector_type(4)));
typedef unsigned u32x4 __attribute__((ext_vector_type(4)));
constexpr int BM = 256, BK = 64, HALF = 128, HTB = HALF * BK * 2  , STAGE_BYTES = 8 * HTB, NXCD = 8, WGM = 8;

__host__ __device__ __forceinline__ int lds_byte(int r, int c) { const int st = (r >> 4) * 2 + (c >> 5), rr = r & 15, cc = c & 31, ob = rr * 64 + cc * 2; return st * 1024 + (ob ^ (((ob >> 9) & 1) << 5)); }
__host__ __device__ __forceinline__ void stage_rc(int b, int& R, int& C) { const int st = b / 1024, sb = b % 1024, swz = sb ^ (((sb >> 9) & 1) << 5); R = (st >> 1) * 16 + swz / 64; C = (st & 1) * 32 + (swz % 64) / 2; }
__host__ __device__ __forceinline__ int perm32(int rho) { const int n = rho >> 4, i = rho & 15; return 8 * (i >> 2) + 4 * n + (i & 3); }

typedef int pg8_v4i __attribute__((ext_vector_type(4))); typedef int pg8_v8i __attribute__((ext_vector_type(8)));
__device__ __forceinline__ pg8_v8i pg8_cat(bf16x8 a, bf16x8 b) { return __builtin_shufflevector(__builtin_bit_cast(pg8_v4i, a), __builtin_bit_cast(pg8_v4i, b), 0, 1, 2, 3, 4, 5, 6, 7); }
struct Unit { int pm, pn, kind; };
struct Gemm { const bf16_t* A0; const bf16_t* B0; const bf16_t* A1; const bf16_t* B1; int K; };

struct StaticOrder {
    int nM, nN, nwg, G, c;
    __host__ __device__ void init(int M, int N, int G_, int c_) { nM = M / BM; nN = N / BM; nwg = nM * nN; G = G_; c = c_; }
    __host__ __device__ bool next(int i, Unit& u) const {
        const long L = (long)i * G + c; if (L >= nwg) return false;
        int wgid = (int)L; { const int q = nwg / NXCD, r = nwg % NXCD, xcd = wgid % NXCD, off = wgid / NXCD; wgid = (xcd < r ? xcd * (q + 1) : r * (q + 1) + (xcd - r) * q) + off; }
        const int nig = WGM * nN, gid = wgid / nig, fm = gid * WGM, gsz = (nM - fm) < WGM ? (nM - fm) : WGM;
        u.pm = fm + ((wgid % nig) % gsz); u.pn = (wgid % nig) / gsz; u.kind = 0; return true;
    }
    __device__ __forceinline__ void a_ready(const Unit&) const {}
    __device__ __forceinline__ void done(const Unit&) const {}
};

template <class E_> struct EpiInit { static constexpr bool value = false; };
template <class Epi, class Sched, bool ALIGN_EPI = false, bool SP2 = false, bool GATHER = false, bool FP8 = false, int SCW = 127, int SCX = 127>
__device__ __forceinline__ void gemm_phase(PG8_LAS unsigned char* lds, const Gemm g, const Sched& S, const Epi& E, const int* gidx = nullptr) {
    const int tid = threadIdx.x, wid = __builtin_amdgcn_readfirstlane(tid >> 6), lane = tid & 63, wr = wid >> 2, wc = wid & 3, fr = lane & 15, fq = lane >> 4;
    constexpr int ESZ = FP8 ? 1 : 2;
    const int K = g.K, nt = K * ESZ / (BK * 2);
    unsigned voffA[2], voffB[2];
#pragma unroll
    for (int i = 0; i < 2; ++i) { int R, C; stage_rc(tid * 16 + i * 8192, R, C); const int Rb = Epi::PERM ? ((R & ~31) + perm32(R & 31)) : R;
        voffA[i] = (unsigned)(R * K) * (unsigned)ESZ + (unsigned)C * 2u; voffB[i] = (unsigned)(Rb * K) * (unsigned)ESZ + (unsigned)C * 2u; }
    int gR[2], gC[2];
#pragma unroll
    for (int i = 0; i < 2; ++i) stage_rc(tid * 16 + i * 8192, gR[i], gC[i]);
    unsigned cvo[2][2], nvo[2][2];
#define PG8_GOFF(dst, u) do { if constexpr (GATHER) { _Pragma("unroll") for (int h_ = 0; h_ < 2; ++h_) _Pragma("unroll") for (int i_ = 0; i_ < 2; ++i_) dst[h_][i_] = (unsigned)gidx[(u).pm * BM + h_ * HALF + gR[i_]] * (unsigned)K * (unsigned)ESZ + (unsigned)gC[i_] * 2u; } } while (0)
    const size_t kstep = (size_t)(BK * 2);
    const size_t hstep = (size_t)HALF * K * ESZ;
    const size_t tstep = 2 * hstep;
    const unsigned ldsw = (unsigned)wid * 1024u;
    const int aoff = lds_byte(wr * 64 + fr, FP8 ? fq * 16 : fq * 8), boff = lds_byte(wc * 32 + fr, FP8 ? fq * 16 : fq * 8);
    constexpr int KS = FP8 ? 16 : 1024;
#define PG8_SA(b, h) (((b) * 2 + (h)) * HTB)
#define PG8_SB(b, h) ((4 + (b) * 2 + (h)) * HTB)
#define PG8_STAGE(bufoff, gbase, voff) do { _Pragma("unroll") for (int _i = 0; _i < 2; ++_i) \
        __builtin_amdgcn_global_load_lds((const unsigned*)((const char*)(gbase) + (voff)[_i]), (PG8_LAS unsigned*)(lds + (bufoff) + ldsw + _i * 8192), 16, 0, 0); } while (0)
#define PG8_STAGE_A(bufoff, gptr, h, isnext) do { if constexpr (GATHER) { unsigned vo_[2]; vo_[0] = (isnext) ? nvo[h][0] : cvo[h][0]; vo_[1] = (isnext) ? nvo[h][1] : cvo[h][1]; PG8_STAGE(bufoff, gptr, vo_); } else { PG8_STAGE(bufoff, (gptr) + ((h) ? hstep : 0), voffA); } } while (0)
#define PG8_LDA(dst, b, h) do { _Pragma("unroll") for (int m = 0; m < 4; ++m) _Pragma("unroll") for (int k = 0; k < 2; ++k) dst[m][k] = *(const PG8_LAS bf16x8*)(lds + PG8_SA(b, h) + aoff + m * 2048 + k * KS); } while (0)
#define PG8_LDB(dst, b, h) do { _Pragma("unroll") for (int n = 0; n < 2; ++n) _Pragma("unroll") for (int k = 0; k < 2; ++k) dst[n][k] = *(const PG8_LAS bf16x8*)(lds + PG8_SB(b, h) + boff + n * 2048 + k * KS); } while (0)
#define PG8_MMA(ai, bj, At, Bt) do { __builtin_amdgcn_s_setprio(1); if constexpr (FP8) { _Pragma("unroll") for (int m = 0; m < 4; ++m) _Pragma("unroll") for (int n = 0; n < 2; ++n) \
        asm volatile("v_mfma_scale_f32_16x16x128_f8f6f4 %0, %1, %2, %0, %3, %4 op_sel_hi:[0,0,0]" : "+v"(acc[ai][bj][m][n]) : "v"(pg8_cat(Bt[n][0], Bt[n][1])), "v"(pg8_cat(At[m][0], At[m][1])), "v"(scw_), "v"(scx_)); } \
        else { _Pragma("unroll") for (int m = 0; m < 4; ++m) _Pragma("unroll") for (int n = 0; n < 2; ++n) _Pragma("unroll") for (int k = 0; k < 2; ++k) \
        acc[ai][bj][m][n] = __builtin_amdgcn_mfma_f32_16x16x32_bf16(Bt[n][k], At[m][k], acc[ai][bj][m][n], 0, 0, 0); } __builtin_amdgcn_s_setprio(0); } while (0)
#define PG8_WAIT_V(n) asm volatile("s_waitcnt vmcnt(" #n ")" ::: "memory")
#define PG8_WAIT_L(n) asm volatile("s_waitcnt lgkmcnt(" #n ")" ::: "memory")
#define PG8_BAR __builtin_amdgcn_s_barrier()
#define PG8_SCHED __builtin_amdgcn_sched_barrier(0)
    Unit cur, nxt; int ui = 0;
    if (!S.next(0, cur)) return;
    int scw_ = SCW * 0x01010101, scx_ = SCX * 0x01010101; asm volatile("" : "+v"(scw_), "+v"(scx_));
    f32x4 acc[2][2][4][2];
#pragma unroll
    for (int a = 0; a < 2; ++a)
#pragma unroll
        for (int b = 0; b < 2; ++b)
#pragma unroll
            for (int m = 0; m < 4; ++m)
#pragma unroll
                for (int n = 0; n < 2; ++n) acc[a][b][m][n] = (f32x4){0.f, 0.f, 0.f, 0.f};
    if constexpr (EpiInit<Epi>::value) E.init(acc, cur, wr, wc, fr, fq);
    bf16x8 At[4][2], B0[2][2], B1[2][2];
    const char* cA = GATHER ? (const char*)g.A0 : (const char*)(cur.kind ? g.A1 : g.A0) + (size_t)cur.pm * tstep; PG8_GOFF(cvo, cur); const char* cB = (const char*)(cur.kind ? g.B1 : g.B0) + (size_t)cur.pn * tstep;
    S.a_ready(cur);
    if constexpr (SP2) {
        PG8_STAGE(PG8_SB(0, 0), cB, voffB); PG8_STAGE(PG8_SB(0, 1), cB + hstep, voffB); PG8_STAGE_A(PG8_SA(0, 0), cA, 0, false); PG8_STAGE_A(PG8_SA(0, 1), cA, 1, false);
        if (wr == 1) PG8_BAR;
        PG8_WAIT_V(2); PG8_BAR;
        PG8_STAGE(PG8_SB(1, 0), cB + kstep, voffB); PG8_STAGE_A(PG8_SA(1, 0), cA + kstep, 0, false); PG8_STAGE(PG8_SB(1, 1), cB + hstep + kstep, voffB);
        PG8_WAIT_V(6); PG8_BAR;
    } else {
        PG8_STAGE(PG8_SB(0, 0), cB, voffB); PG8_STAGE_A(PG8_SA(0, 0), cA, 0, false); PG8_STAGE(PG8_SB(0, 1), cB + hstep, voffB); PG8_STAGE_A(PG8_SA(0, 1), cA, 1, false);
        if (wr == 1) PG8_BAR;
        PG8_WAIT_V(4); PG8_BAR;
        PG8_STAGE(PG8_SB(1, 0), cB + kstep, voffB); PG8_STAGE_A(PG8_SA(1, 0), cA + kstep, 0, false); PG8_STAGE(PG8_SB(1, 1), cB + hstep + kstep, voffB);
        PG8_WAIT_V(6); PG8_BAR;
    }
    for (;;) {
        const bool has_next = S.next(ui + 1, nxt);
        const char* nA = GATHER ? cA : (has_next ? (const char*)(nxt.kind ? g.A1 : g.A0) + (size_t)nxt.pm * tstep : cA); if (has_next) PG8_GOFF(nvo, nxt); const char* nB = has_next ? (const char*)(nxt.kind ? g.B1 : g.B0) + (size_t)nxt.pn * tstep : cB;
#pragma unroll 1
        for (int t = 0; t < nt; t += 2) {
            const bool last = (t == nt - 2);
            const char* a1 = cA + (size_t)(t + 1) * kstep;
            const char* a2 = last ? nA : cA + (size_t)(t + 2) * kstep; const char* b2 = last ? nB : cB + (size_t)(t + 2) * kstep;
            const char* a3 = a2 + kstep; const char* b3 = b2 + kstep; const bool nx_ = last && has_next;
            if (last && has_next) S.a_ready(nxt);
            if constexpr (SP2) {
            PG8_LDB(B0, 0, 0); PG8_LDB(B1, 0, 1); PG8_SCHED; PG8_LDA(At, 0, 0); PG8_STAGE_A(PG8_SA(1, 1), a1, 1, false);
            PG8_WAIT_V(8); PG8_WAIT_L(0); PG8_BAR; PG8_MMA(0, 0, At, B0); PG8_MMA(0, 1, At, B1); PG8_BAR; PG8_SCHED;
            PG8_LDA(At, 0, 1); PG8_STAGE(PG8_SB(0, 0), b2, voffB); PG8_STAGE(PG8_SB(0, 1), b2 + hstep, voffB); PG8_STAGE_A(PG8_SA(0, 0), a2, 0, nx_);
            PG8_WAIT_V(8); PG8_WAIT_L(0); PG8_BAR; PG8_MMA(1, 0, At, B0); PG8_MMA(1, 1, At, B1); PG8_BAR; PG8_SCHED;
            PG8_LDB(B0, 1, 0); PG8_LDB(B1, 1, 1); PG8_SCHED; PG8_LDA(At, 1, 0); PG8_STAGE_A(PG8_SA(0, 1), a2, 1, nx_);
            PG8_WAIT_V(8); PG8_WAIT_L(0); PG8_BAR; PG8_MMA(0, 0, At, B0); PG8_MMA(0, 1, At, B1); PG8_BAR; PG8_SCHED;
            PG8_LDA(At, 1, 1); PG8_STAGE(PG8_SB(1, 0), b3, voffB); PG8_STAGE(PG8_SB(1, 1), b3 + hstep, voffB); PG8_STAGE_A(PG8_SA(1, 0), a3, 0, nx_);
            PG8_WAIT_V(8); PG8_WAIT_L(0); PG8_BAR; PG8_MMA(1, 0, At, B0); PG8_MMA(1, 1, At, B1); PG8_BAR; PG8_SCHED;
            } else {
            PG8_LDB(B0, 0, 0); PG8_SCHED; PG8_LDA(At, 0, 0); PG8_STAGE_A(PG8_SA(1, 1), a1, 1, false);
            PG8_WAIT_L(8); PG8_BAR; PG8_WAIT_L(0); PG8_MMA(0, 0, At, B0); PG8_BAR; PG8_SCHED;
            PG8_LDB(B1, 0, 1); PG8_STAGE(PG8_SB(0, 0), b2, voffB);
            PG8_BAR; PG8_WAIT_L(0); PG8_MMA(0, 1, At, B1); PG8_BAR;
            PG8_LDA(At, 0, 1); PG8_STAGE_A(PG8_SA(0, 0), a2, 0, nx_);
            PG8_BAR; PG8_WAIT_L(0); PG8_MMA(1, 0, At, B0); PG8_BAR; PG8_SCHED;
            PG8_STAGE(PG8_SB(0, 1), b2 + hstep, voffB);
            PG8_WAIT_V(6); PG8_BAR; PG8_MMA(1, 1, At, B1); PG8_BAR;
            PG8_LDB(B0, 1, 0); PG8_SCHED; PG8_LDA(At, 1, 0); PG8_STAGE_A(PG8_SA(0, 1), a2, 1, nx_);
            PG8_WAIT_L(8); PG8_BAR; PG8_WAIT_L(0); PG8_MMA(0, 0, At, B0); PG8_BAR; PG8_SCHED;
            PG8_LDB(B1, 1, 1); PG8_STAGE(PG8_SB(1, 0), b3, voffB);
            PG8_BAR; PG8_WAIT_L(0); PG8_MMA(0, 1, At, B1); PG8_BAR;
            PG8_LDA(At, 1, 1); PG8_STAGE_A(PG8_SA(1, 0), a3, 0, nx_);
            PG8_BAR; PG8_WAIT_L(0); PG8_MMA(1, 0, At, B0); PG8_BAR; PG8_SCHED;
            PG8_STAGE(PG8_SB(1, 1), b3 + hstep, voffB);
            PG8_WAIT_V(6); PG8_BAR; PG8_MMA(1, 1, At, B1); PG8_BAR;
            }
        }
        if constexpr (ALIGN_EPI) { if (wr == 0) PG8_BAR; }
        if constexpr (FP8) asm volatile("s_nop 15\n\ts_nop 7" ::: "memory");
        if constexpr (!Epi::AFTER_DRAIN) { int fr_ = fr, fq_ = fq; asm volatile("" : "+v"(fr_), "+v"(fq_)); if constexpr (Epi::REP > 1) { E(acc, cur, wr, wc, fr_, fq_); asm volatile("" ::: "memory"); } E(acc, cur, wr, wc, fr_, fq_); S.done(cur); }
        if (!has_next) break;
#pragma unroll
        for (int a = 0; a < 2; ++a)
#pragma unroll
            for (int b = 0; b < 2; ++b)
#pragma unroll
                for (int m = 0; m < 4; ++m)
#pragma unroll
                    for (int n = 0; n < 2; ++n) acc[a][b][m][n] = (f32x4){0.f, 0.f, 0.f, 0.f};
        cur = nxt; cA = nA; cB = nB; ++ui;
        if constexpr (GATHER) { _Pragma("unroll") for (int h_ = 0; h_ < 2; ++h_) _Pragma("unroll") for (int i_ = 0; i_ < 2; ++i_) cvo[h_][i_] = nvo[h_][i_]; }
        if constexpr (ALIGN_EPI) { if (wr == 1) PG8_BAR; }
    }
    PG8_WAIT_V(0);
    if constexpr (!ALIGN_EPI) { if (wr == 0) PG8_BAR; }
    PG8_BAR;
    if constexpr (Epi::AFTER_DRAIN) { E.fused(acc, cur, wr, wc, fr, fq, lds, wid, lane); S.done(cur); }
#undef PG8_SA
#undef PG8_SB
#undef PG8_STAGE
#undef PG8_STAGE_A
#undef PG8_GOFF
#undef PG8_LDA
#undef PG8_LDB
#undef PG8_MMA
#undef PG8_WAIT_V
#undef PG8_WAIT_L
#undef PG8_BAR
#undef PG8_SCHED
}
}
namespace pg8 {
typedef unsigned u32x2 __attribute__((ext_vector_type(2)));
__device__ __forceinline__ unsigned xcd_remap(int L_, int nwg) { const int q = nwg / NXCD, r = nwg % NXCD, xcd = L_ % NXCD, off = L_ / NXCD; return (unsigned)((xcd < r ? xcd * (q + 1) : r * (q + 1) + (xcd - r) * q) + off); }

struct SchedP1 {
    int G, c;
    __device__ bool next(int i, Unit& u) const {
        const int Lx = i * G + c; if (Lx >= 1280) return false;
        if (Lx < 896) { const int wgid = (int)xcd_remap(Lx, 896); const int nig = 8 * 14, gid = wgid / nig, fm = gid * 8; u.pm = fm + ((wgid % nig) % 8); u.pn = (wgid % nig) / 8; u.kind = 0; }
        else { const int wgid = (int)xcd_remap(Lx - 896, 384); u.pm = wgid % 6; u.pn = wgid / 6; u.kind = 1; }
        return true;
    }
    __device__ __forceinline__ void a_ready(const Unit&) const {}
    __device__ __forceinline__ void done(const Unit&) const {}
};
struct EpiInProj {
    static constexpr int REP = REP_EpiInProj;
    static constexpr bool PERM = true, AFTER_DRAIN = false;
    const float* rstd1; const float* rope; const float* gq; const float* gk;
    bf16_t *qn, *kn; unsigned char* v; bf16_t* hyT; unsigned char* gates;
    __device__ __forceinline__ void operator()(const f32x4 (&acc)[2][2][4][2], const Unit& u, int wr, int wc, int fr, int fq) const {
        if (u.kind == 1) {
            const int tok0 = u.pn * BM, b = tok0 / L, l0 = tok0 % L;
            f32x4 rs[2][2];
#pragma unroll
            for (int bj = 0; bj < 2; ++bj)
#pragma unroll
                for (int n = 0; n < 2; ++n) rs[bj][n] = *(const f32x4*)(rstd1 + tok0 + bj * HALF + wc * 32 + 8 * fq + 4 * n);
#pragma unroll
            for (int ai = 0; ai < 2; ++ai)
#pragma unroll
                for (int m = 0; m < 4; ++m) {
                    const int r = u.pm * BM + ai * HALF + wr * 64 + m * 16 + fr;
                    bf16_t* rowp = hyT + ((size_t)b * HYC + r) * L + l0 + wc * 32 + 8 * fq;
#pragma unroll
                    for (int bj = 0; bj < 2; ++bj) { const f32x4 v0 = acc[ai][bj][m][0] * rs[bj][0], v1 = acc[ai][bj][m][1] * rs[bj][1];
                        u32x4 w; w.x = pk2(v0[0], v0[1]); w.y = pk2(v0[2], v0[3]); w.z = pk2(v1[0], v1[1]); w.w = pk2(v1[2], v1[3]);
                        __builtin_nontemporal_store(w, (u32x4*)(rowp + bj * HALF)); }
                }
            return;
        }
        const int row0 = u.pm * BM + wr * 64 + fr;
        float rr8[8];
#pragma unroll
        for (int r = 0; r < 8; ++r) rr8[r] = rstd1[row0 + (r >> 2) * HALF + (r & 3) * 16];
        if (u.pn < 4) {
            const int gidx = u.pn * 4 + wc, hm = gidx & 7; const bool isq = gidx < 8;
            const float* gain = isq ? gq : gk; bf16_t* dst = isq ? qn : kn;
            float gp[2][8];
#pragma unroll
            for (int bj = 0; bj < 2; ++bj)
#pragma unroll
                for (int t = 0; t < 8; ++t) { const int d = (bj == 0 && fq < 2) ? (4 * fq + (t >> 1) + 8 * (t & 1)) : (32 * bj + 8 * fq + t); gp[bj][t] = gain[d]; }
            const float sc = isq ? QSCALE : 1.0f;
#pragma unroll
            for (int ai = 0; ai < 2; ++ai)
#pragma unroll
                for (int m = 0; m < 4; ++m) {
                    const int tok = row0 + ai * HALF + m * 16, b = tok / L, l = tok % L;
                    const float rr = rr8[ai * 4 + m];
                    float y[2][8]; float ss = 0.f;
#pragma unroll
                    for (int bj = 0; bj < 2; ++bj)
#pragma unroll
                        for (int t = 0; t < 8; ++t) { y[bj][t] = acc[ai][bj][m][t >> 2][t & 3] * rr; ss += y[bj][t] * y[bj][t]; }
                    ss += __shfl_xor(ss, 16); ss += __shfl_xor(ss, 32);
                    const float rn = __builtin_amdgcn_rsqf(ss * (1.0f / 64) + EPS);
#pragma unroll
                    for (int bj = 0; bj < 2; ++bj)
#pragma unroll
                        for (int t = 0; t < 8; ++t) y[bj][t] *= rn * gp[bj][t];
                    if (fq < 2) {
                        const f32x4 cs = *(const f32x4*)(rope + l * 8 + 4 * fq), sn = *(const f32x4*)(rope + L * 8 + l * 8 + 4 * fq);
#pragma unroll
                        for (int j = 0; j < 4; ++j) { const float a = y[0][2 * j], c = y[0][2 * j + 1]; y[0][2 * j] = a * cs[j] - c * sn[j]; y[0][2 * j + 1] = c * cs[j] + a * sn[j]; }
                    }
                    bf16_t* rowp = isq ? dst + (((size_t)b * 8 + hm) * L + l) * 64 + 8 * fq : dst + ((size_t)b * 8 + hm) * L * 64 + (size_t)(l >> 6) * 4096 + fq * 512 + (m + 8 * (fr & 3) + 4 * ((fr >> 2) & 1) + 32 * (fr >> 3)) * 8;
                    const int bstep = isq ? 32 : 2048;
#pragma unroll
                    for (int bj = 0; bj < 2; ++bj) { u32x4 w; w.x = pk2(y[bj][0] * sc, y[bj][1] * sc); w.y = pk2(y[bj][2] * sc, y[bj][3] * sc); w.z = pk2(y[bj][4] * sc, y[bj][5] * sc); w.w = pk2(y[bj][6] * sc, y[bj][7] * sc);
                        *(u32x4*)(rowp + bstep * bj) = w; }
                }
        } else if (u.pn < 6) {
#pragma unroll
            for (int ai = 0; ai < 2; ++ai) {
                const int tok = row0 + ai * HALF, b = tok / L, l = tok % L;
                const float r0 = rr8[ai * 4], r1 = rr8[ai * 4 + 1], r2 = rr8[ai * 4 + 2], r3 = rr8[ai * 4 + 3];
#pragma unroll
                for (int bj = 0; bj < 2; ++bj) {
                    unsigned char* base = v + ((size_t)b * NH + (u.pn - 4) * 2 + bj) * L * VD + (size_t)(l >> 6) * 8192 + wc * 2048 + (fr >> 3) * 1024 + (((fr >> 2) & 1) * 32 + 8 * fq) * 16 + (fr & 3) * 4;
#pragma unroll
                    for (int t = 0; t < 8; ++t)
                        *(unsigned*)(base + t * 16) = pk4_fp8(acc[ai][bj][0][t >> 2][t & 3] * r0, acc[ai][bj][1][t >> 2][t & 3] * r1, acc[ai][bj][2][t >> 2][t & 3] * r2, acc[ai][bj][3][t >> 2][t & 3] * r3);
                }
            }
        } else {
#pragma unroll
            for (int ai = 0; ai < 2; ++ai)
#pragma unroll
                for (int m = 0; m < 4; ++m) {
                    const int tok = row0 + ai * HALF + m * 16; const float rr = -1.4426950408889634f * rr8[ai * 4 + m];
#pragma unroll
                    for (int bj = 0; bj < 2; ++bj) { unsigned w0 = 0, w1 = 0;
#pragma unroll
                        for (int t = 0; t < 8; ++t) {
                            const float s = __builtin_amdgcn_rcpf((1.0f / 255.0f) + __builtin_amdgcn_exp2f(rr * acc[ai][bj][m][t >> 2][t & 3] - 7.994353436858858f));
                            if (t < 4) w0 = __builtin_amdgcn_cvt_pk_u8_f32(s, t & 3, w0); else w1 = __builtin_amdgcn_cvt_pk_u8_f32(s, t & 3, w1); }
                        u32x2 w; w.x = w0; w.y = w1;
                        __builtin_nontemporal_store(w, (u32x2*)(gates + (size_t)tok * GC + (u.pn - 6) * BM + bj * HALF + wc * 32 + 8 * fq)); }
                }
        }
    }
};

struct SchedP3 {
    StaticOrder so;
    __device__ bool next(int i, Unit& u) const { if (i >= 2) return false; so.next(0, u); u.kind = i; return true; }
    __device__ __forceinline__ void a_ready(const Unit&) const {}
    __device__ __forceinline__ void done(const Unit&) const {}
};
struct EpiMerge {
    static constexpr int REP = REP_EpiMerge;
    static constexpr bool PERM = true, AFTER_DRAIN = false;
    const unsigned char* gates; bf16_t* tmpm; bf16_t* merged;
    __device__ __forceinline__ void operator()(const f32x4 (&acc)[2][2][4][2], const Unit& u, int wr, int wc, int fr, int fq) const {
        const int row0 = u.pm * BM + wr * 64 + fr, col0 = u.pn * BM + wc * 32 + 8 * fq;
#pragma unroll
        for (int ai = 0; ai < 2; ++ai) {
            u32x2 g[4][2]; u32x4 pr[4][2];
#pragma unroll
            for (int m = 0; m < 4; ++m)
#pragma unroll
                for (int bj = 0; bj < 2; ++bj) { const int tok = row0 + ai * HALF + m * 16, col = col0 + bj * HALF;
                    g[m][bj] = *(const u32x2*)(gates + (size_t)tok * GC + u.kind * 1024 + col);
                    if (u.kind == 1) pr[m][bj] = *(const u32x4*)(tmpm + (size_t)tok * D + col); }
#pragma unroll
            for (int m = 0; m < 4; ++m)
#pragma unroll
                for (int bj = 0; bj < 2; ++bj) { const int tok = row0 + ai * HALF + m * 16, col = col0 + bj * HALF;
                    float o[8];
                    { const f32x4 a0 = acc[ai][bj][m][0] * (1.0f / 255.0f), a1 = acc[ai][bj][m][1] * (1.0f / 255.0f); const unsigned g0 = g[m][bj][0], g1 = g[m][bj][1];
                      o[0] = (float)((g0 >> 0) & 0xffu) * a0[0]; o[1] = (float)((g0 >> 8) & 0xffu) * a0[1]; o[2] = (float)((g0 >> 16) & 0xffu) * a0[2]; o[3] = (float)((g0 >> 24) & 0xffu) * a0[3];
                      o[4] = (float)((g1 >> 0) & 0xffu) * a1[0]; o[5] = (float)((g1 >> 8) & 0xffu) * a1[1]; o[6] = (float)((g1 >> 16) & 0xffu) * a1[2]; o[7] = (float)((g1 >> 24) & 0xffu) * a1[3]; }
                    if (u.kind == 1) {
#pragma unroll
                        for (int t = 0; t < 4; ++t) { o[2 * t] += bflo(pr[m][bj][t]); o[2 * t + 1] += bfhi(pr[m][bj][t]); } }
                    u32x4 w; w.x = pk2(o[0], o[1]); w.y = pk2(o[2], o[3]); w.z = pk2(o[4], o[5]); w.w = pk2(o[6], o[7]);
                    *(u32x4*)((u.kind == 1 ? merged : tmpm) + (size_t)tok * D + col) = w; }
        }
    }
};

struct EpiOutProj {
    static constexpr int REP = REP_EpiOutProj;
    static constexpr bool PERM = false, AFTER_DRAIN = false;
    const float* x; float* out;
    __device__ __forceinline__ void init(f32x4 (&acc)[2][2][4][2], const Unit& u, int wr, int wc, int fr, int fq) const {
        const int row0 = u.pm * BM + wr * 64 + fr, col0 = u.pn * BM + wc * 32 + 4 * fq;
#pragma unroll
        for (int ai = 0; ai < 2; ++ai)
#pragma unroll
            for (int m = 0; m < 4; ++m)
#pragma unroll
                for (int bj = 0; bj < 2; ++bj)
#pragma unroll
                    for (int n = 0; n < 2; ++n) acc[ai][bj][m][n] = __builtin_nontemporal_load((const f32x4*)(x + (size_t)(row0 + ai * HALF + m * 16) * D + col0 + bj * HALF + n * 16));
    }
    __device__ __forceinline__ void operator()(const f32x4 (&acc)[2][2][4][2], const Unit& u, int wr, int wc, int fr, int fq) const {
        const int row0 = u.pm * BM + wr * 64 + fr, col0 = u.pn * BM + wc * 32 + 4 * fq;
#pragma unroll
        for (int ai = 0; ai < 2; ++ai)
#pragma unroll
            for (int m = 0; m < 4; ++m)
#pragma unroll
                for (int bj = 0; bj < 2; ++bj)
#pragma unroll
                    for (int n = 0; n < 2; ++n) *(f32x4*)(out + (size_t)(row0 + ai * HALF + m * 16) * D + col0 + bj * HALF + n * 16) = acc[ai][bj][m][n];
    }
};
struct EpiOutProjLate {
    static constexpr int REP = 1;
    static constexpr bool PERM = false, AFTER_DRAIN = false;
    const float* x; float* out;
    __device__ __forceinline__ void operator()(const f32x4 (&acc)[2][2][4][2], const Unit& u, int wr, int wc, int fr, int fq) const {
        const int row0 = u.pm * BM + wr * 64 + fr, col0 = u.pn * BM + wc * 32 + 4 * fq;
#pragma unroll
        for (int ai = 0; ai < 2; ++ai) {
            f32x4 xr[4][2][2];
#pragma unroll
            for (int m = 0; m < 4; ++m)
#pragma unroll
                for (int bj = 0; bj < 2; ++bj)
#pragma unroll
                    for (int n = 0; n < 2; ++n) xr[m][bj][n] = __builtin_nontemporal_load((const f32x4*)(x + (size_t)(row0 + ai * HALF + m * 16) * D + col0 + bj * HALF + n * 16));
#pragma unroll
            for (int m = 0; m < 4; ++m)
#pragma unroll
                for (int bj = 0; bj < 2; ++bj)
#pragma unroll
                    for (int n = 0; n < 2; ++n) *(f32x4*)(out + (size_t)(row0 + ai * HALF + m * 16) * D + col0 + bj * HALF + n * 16) = acc[ai][bj][m][n] + xr[m][bj][n];
        }
    }
};
template <> struct EpiInit<EpiOutProj> { static constexpr bool value = true; };

struct SchedP7 {
    int G, c;
    __device__ bool next(int i, Unit& u) const {
        const int Lx = i * G + c; if (Lx >= 1024) return false;
        const int wgid = (int)xcd_remap(Lx, 1024), e = wgid >> 6, wl = wgid & 63, pmi = wl & 7, pni = ((wl >> 3) & 3) + 4 * (wl >> 5);
        u.pm = ((pmi >> 1) * 16 + e) * 2 + (pmi & 1); u.pn = e * 8 + pni; u.kind = e >> 3; return true;
    }
    __device__ __forceinline__ void a_ready(const Unit&) const {}
    __device__ __forceinline__ void done(const Unit&) const {}
};
struct EpiGateUp {
    static constexpr int REP = REP_EpiGateUp;
    static constexpr bool PERM = true, AFTER_DRAIN = false;
    unsigned char* hbuf;
    __device__ __forceinline__ void operator()(const f32x4 (&acc)[2][2][4][2], const Unit& u, int wr, int wc, int fr, int fq) const {
        const int row0 = u.pm * BM + wr * 64 + fr, col0 = (u.pn & 7) * HALF + wc * 32 + 8 * fq;
#pragma unroll
        for (int ai = 0; ai < 2; ++ai)
#pragma unroll
            for (int m = 0; m < 4; ++m) { float h[8];
#pragma unroll
                for (int t = 0; t < 8; ++t) { const float g = acc[ai][0][m][t >> 2][t & 3], up = acc[ai][1][m][t >> 2][t & 3];
                    h[t] = fminf(fmaxf(g * __builtin_amdgcn_rcpf(1.0f + __builtin_amdgcn_exp2f(-1.4426950408889634f * g)) * up, -448.f), 448.f); }
                u32x2 w; w.x = pk4_fp8(h[0], h[1], h[2], h[3]); w.y = pk4_fp8(h[4], h[5], h[6], h[7]);
                *(u32x2*)(hbuf + (size_t)(row0 + ai * HALF + m * 16) * EH + col0) = w; }
    }
};
struct SchedP8 {
    int G, c;
    __device__ bool next(int i, Unit& u) const {
        const int Lx = i * G + c; if (Lx >= 512) return false;
        const int wgid = (int)xcd_remap(Lx, 512), e = wgid >> 5, wl = wgid & 31, pmi = wl & 7, pni = wl >> 3;
        u.pm = ((pmi >> 1) * 16 + e) * 2 + (pmi & 1); u.pn = e * 4 + pni; u.kind = e >> 3; return true;
    }
    __device__ __forceinline__ void a_ready(const Unit&) const {}
    __device__ __forceinline__ void done(const Unit&) const {}
};
struct EpiDown {
    static constexpr int REP = REP_EpiDown;
    static constexpr bool PERM = true, AFTER_DRAIN = false;
    const float* selgate; unsigned char* slab;
    __device__ __forceinline__ void operator()(const f32x4 (&acc)[2][2][4][2], const Unit& u, int wr, int wc, int fr, int fq) const {
        const int row0 = u.pm * BM + wr * 64 + fr, col0 = (u.pn & 3) * BM + wc * 32 + 8 * fq;
        float gts[8];
#pragma unroll
        for (int r = 0; r < 8; ++r) gts[r] = selgate[row0 + (r >> 2) * HALF + (r & 3) * 16];
#pragma unroll
        for (int ai = 0; ai < 2; ++ai)
#pragma unroll
            for (int m = 0; m < 4; ++m) { const int row = row0 + ai * HALF + m * 16; const float gt = gts[ai * 4 + m];
#pragma unroll
                for (int bj = 0; bj < 2; ++bj) { const f32x4 v0 = acc[ai][bj][m][0] * gt, v1 = acc[ai][bj][m][1] * gt;
                    u32x2 w; w.x = pk4_fp8(v0[0], v0[1], v0[2], v0[3]); w.y = pk4_fp8(v1[0], v1[1], v1[2], v1[3]);
                    *(u32x2*)(slab + (size_t)row * D + col0 + bj * HALF) = w; } }
    }
};
}
namespace attn {
typedef short bf16x8 __attribute__((ext_vector_type(8)));
typedef short s16x4 __attribute__((ext_vector_type(4)));
typedef float f32x16 __attribute__((ext_vector_type(16)));
typedef unsigned u32x4 __attribute__((ext_vector_type(4)));
typedef float f32x2_t __attribute__((ext_vector_type(2))); typedef __bf16 bf16x2_t __attribute__((ext_vector_type(2)));
typedef __attribute__((address_space(3))) const char* lds_cptr;
typedef short v4i16_t __attribute__((ext_vector_type(4)));
constexpr int SLOT = 24576, NSLOT = 3, OFF_K1 = 0, OFF_K2 = 8192, OFF_V = 16384;
typedef int i32x8 __attribute__((ext_vector_type(8)));
constexpr int OFF_TB = 98304;
constexpr int OFF_X = 0, OFF_STG = 65536, OFF_WSF = 98304;
__device__ __forceinline__ int crow(int r, int hi) { return (r & 3) + 8 * (r >> 2) + 4 * hi; }
__device__ __forceinline__ void glds16(const void* gsrc, unsigned lds_dst) { unsigned keep;
    asm volatile("s_mov_b32 %0, m0\n\ts_mov_b32 m0, %2\n\ts_nop 0\n\tglobal_load_lds_dwordx4 %1, off\n\ts_mov_b32 m0, %0" : "=&s"(keep) : "v"(gsrc), "s"(lds_dst) : "memory"); }
__device__ __forceinline__ void glds16s(const void* sbase, unsigned voff, unsigned lds_dst) { unsigned keep;
    asm volatile("s_mov_b32 %0, m0\n\ts_mov_b32 m0, %3\n\ts_nop 0\n\tglobal_load_lds_dwordx4 %1, %2\n\ts_mov_b32 m0, %0" : "=&s"(keep) : "v"(voff), "s"(sbase), "s"(lds_dst) : "memory"); }
__device__ __forceinline__ void glds16s_nt(const void* sbase, unsigned voff, unsigned lds_dst) { unsigned keep;
    asm volatile("s_mov_b32 %0, m0\n\ts_mov_b32 m0, %3\n\ts_nop 0\n\tglobal_load_lds_dwordx4 %1, %2 nt\n\ts_mov_b32 m0, %0" : "=&s"(keep) : "v"(voff), "s"(sbase), "s"(lds_dst) : "memory"); }
struct WConv { const float* wg; const float* wu; const float* wd; unsigned char* ws; int blk; };
__device__ __forceinline__ int pk4_bf8(float a, float b, float c, float d) { int w = 0; w = __builtin_amdgcn_cvt_pk_bf8_f32(a, b, w, false); w = __builtin_amdgcn_cvt_pk_bf8_f32(c, d, w, true); return w; }
__device__ __forceinline__ int pk4_fp8n(float a, float b, float c, float d) { int w; asm("v_cvt_pk_fp8_f32 %0, %1, %2" : "=v"(w) : "v"(a), "v"(b)); asm("v_cvt_pk_fp8_f32 %0, %1, %2 op_sel:[0,0,1]" : "+v"(w) : "v"(c), "v"(d)); return w; }
__device__ __forceinline__ unsigned cvtpk(float lo, float hi) { f32x2_t v = {lo, hi}; bf16x2_t b = __builtin_convertvector(v, bf16x2_t); return __builtin_bit_cast(unsigned, b); }
__device__ __forceinline__ s16x4 vtr(lds_cptr p) { return __builtin_bit_cast(s16x4, __builtin_amdgcn_ds_read_tr16_b64_v4i16((__attribute__((address_space(3))) v4i16_t*)p)); }
#define ATT_WAIT_BAR(N) asm volatile("s_waitcnt vmcnt(" #N ") lgkmcnt(0)\n\ts_barrier" ::: "memory")

__device__ __forceinline__ void attn_unit(int b, int h, int qb, const bf16* qn, const bf16* kn, const unsigned char* vv, bf16* attn_out, const float* subln, float M2, float lam,
                                          __attribute__((address_space(3))) unsigned char* lds, const WConv wc) {
    const int tid = threadIdx.x, lane = tid & 63, r32 = lane & 31, hi = lane >> 5; const int wid = __builtin_amdgcn_readfirstlane(tid >> 6);
    const unsigned lds0 = (unsigned)(uintptr_t)lds;
    const bf16* k1b = kn + (((size_t)b * 8 + h * 2 + 0) * L) * 64 + wid * 512;
    const bf16* k2b = kn + (((size_t)b * 8 + h * 2 + 1) * L) * 64 + wid * 512;
    const unsigned char* vpb = vv + (((size_t)b * NH + h) * L) * VD + wid * 1024;
    const unsigned lofs = (unsigned)lane * 16u;
#define ATT_DMA(t, slot) do { \
        glds16s(k1b + (size_t)(t) * 64 * 64, lofs, (unsigned)__builtin_amdgcn_readfirstlane(lds0 + (slot) + OFF_K1 + wid * 1024)); \
        glds16s(k2b + (size_t)(t) * 64 * 64, lofs, (unsigned)__builtin_amdgcn_readfirstlane(lds0 + (slot) + OFF_K2 + wid * 1024)); \
        glds16s(vpb + (size_t)(t) * 8192, lofs, (unsigned)__builtin_amdgcn_readfirstlane(lds0 + (slot) + OFF_V + wid * 1024)); } while (0)
    constexpr int NT = L / 64;
    ATT_DMA(0, 0); ATT_DMA(1, SLOT);
    const int q0 = qb * 256 + wid * 32;
    const bf16* Q1 = qn + (((size_t)b * 8 + h * 2 + 0) * L + q0) * 64; const bf16* Q2 = qn + (((size_t)b * 8 + h * 2 + 1) * L + q0) * 64;
    bf16x8 qa[4], qc[4];
    { const int lq = opq_i(lane); const unsigned qoff = (unsigned)((lq & 31) * 64 + (lq >> 5) * 8);
#pragma unroll
    for (int d0 = 0; d0 < 4; ++d0) { qa[d0] = *reinterpret_cast<const bf16x8*>(Q1 + qoff + d0 * 16); qc[d0] = *reinterpret_cast<const bf16x8*>(Q2 + qoff + d0 * 16); } }
    f32x16 cinit;
    { const float ns = 8.5f - M2;
#pragma unroll
      for (int r = 0; r < 16; ++r) cinit[r] = ns; }
    f32x16 o1[4], o2[4];
#pragma unroll
    for (int d = 0; d < 4; ++d) { o1[d] = f32x16{}; o2[d] = f32x16{}; }
    float l1 = 0.f, l2 = 0.f;
    const lds_cptr lds3 = (lds_cptr)lds;
    const lds_cptr kp0 = lds3 + hi * 1024 + r32 * 16;
    const lds_cptr fp0 = lds3 + lane * 16;
    int sl_cur = 0, sl_nn = 2 * SLOT;
#define ATT_FRAG(OFF) ({ const u32x4 lo_ = *(const __attribute__((address_space(3))) u32x4*)(fp0 + sl_cur + (OFF)), hi_ = *(const __attribute__((address_space(3))) u32x4*)(fp0 + sl_cur + (OFF) + 1024); \
        (i32x8){(int)lo_[0], (int)lo_[1], (int)lo_[2], (int)lo_[3], (int)hi_[0], (int)hi_[1], (int)hi_[2], (int)hi_[3]}; })
#define ATT_MMA_PV(A, B, C) __builtin_amdgcn_mfma_scale_f32_32x32x64_f8f6f4(A, B, C, 0, 0, 0, 127, 0, 127)
#define ATT_QK(P0, P1, KOFF, QR) do { const lds_cptr kp_ = kp0 + sl_cur + (KOFF); _Pragma("unroll") for (int d0 = 0; d0 < 4; ++d0) { \
            const bf16x8 b0_ = *(const __attribute__((address_space(3))) bf16x8*)(kp_ + d0 * 2048); \
            const bf16x8 b1_ = *(const __attribute__((address_space(3))) bf16x8*)(kp_ + d0 * 2048 + 512); \
            if (d0 == 0) { P0 = __builtin_amdgcn_mfma_f32_32x32x16_bf16(b0_, QR[0], cinit, 0, 0, 0); P1 = __builtin_amdgcn_mfma_f32_32x32x16_bf16(b1_, QR[0], cinit, 0, 0, 0); } \
            else { P0 = __builtin_amdgcn_mfma_f32_32x32x16_bf16(b0_, QR[d0], P0, 0, 0, 0); P1 = __builtin_amdgcn_mfma_f32_32x32x16_bf16(b1_, QR[d0], P1, 0, 0, 0); } } } while (0)
#define ATT_SM(P0, P1, LS, PW) do { \
        _Pragma("unroll") for (int r = 0; r < 16; ++r) P0[r] = __builtin_amdgcn_exp2f(P0[r]);     \
        _Pragma("unroll") for (int r = 0; r < 16; ++r) P1[r] = __builtin_amdgcn_exp2f(P1[r]); \
        f32x2_t s0_ = {P0[0], P0[1]}, s1_ = {P0[2], P0[3]}, s2_ = {P1[0], P1[1]}, s3_ = {P1[2], P1[3]};     \
        _Pragma("unroll") for (int r = 4; r < 16; r += 4) { s0_ += (f32x2_t){P0[r], P0[r + 1]}; s1_ += (f32x2_t){P0[r + 2], P0[r + 3]}; s2_ += (f32x2_t){P1[r], P1[r + 1]}; s3_ += (f32x2_t){P1[r + 2], P1[r + 3]}; } \
        { const f32x2_t st_ = (s0_ + s1_) + (s2_ + s3_); LS += st_[0] + st_[1]; } \
        _Pragma("unroll") for (int j = 0; j < 4; ++j) { PW[j] = pk4_fp8n(P0[4 * j], P0[4 * j + 1], P0[4 * j + 2], P0[4 * j + 3]); PW[4 + j] = pk4_fp8n(P1[4 * j], P1[4 * j + 1], P1[4 * j + 2], P1[4 * j + 3]); } } while (0)
    for (int t = 0; t < NT; ++t) {
        if (t + 1 < NT) { ATT_WAIT_BAR(3); } else { ATT_WAIT_BAR(0); }
        if (t < 48) {
            const int tau = wc.blk * 24 + (t >> 1);
            int e, kb, nb, drow0; const float* srcm; size_t dofs;
            if (tau < 4096) { e = tau >> 8; const int r = tau & 255, mat = r >> 7; kb = (r >> 4) & 7; nb = r & 15; srcm = mat ? wc.wu : wc.wg;
                drow0 = (nb >> 1) * 256 + mat * 128 + (nb & 1) * 64; dofs = (e < 8 ? WS_WGU0 : WS_WGU1) + (size_t)(e & 7) * (2 * MiB); }
            else { const int t2 = tau - 4096; e = t2 >> 7; const int r = t2 & 127; kb = r >> 4; nb = r & 15; srcm = wc.wd; drow0 = nb * 64; dofs = (e < 8 ? WS_WD0 : WS_WD1) + (size_t)(e & 7) * MiB; }
            if (!(t & 1)) {
                const float* s = srcm + (size_t)e * (D * EH) + (size_t)(kb * 128 + wid * 16) * 1024 + nb * 64;
                const unsigned voff = (unsigned)(((lane >> 4) * 1024 + (lane & 15) * 4) * 4);
#pragma unroll
                for (int i = 0; i < 4; ++i) glds16s_nt(s + i * 4096, voff, (unsigned)__builtin_amdgcn_readfirstlane(lds0 + OFF_TB + (wid * 4 + i) * 1024));
            } else {
                const unsigned tpa = lds0 + OFF_TB + wid * 4096 + (unsigned)opq_i(lane) * 4u;
                float v[16];
                asm volatile("ds_read2st64_b32 %0, %8 offset1:1\n\tds_read2st64_b32 %1, %8 offset0:2 offset1:3\n\tds_read2st64_b32 %2, %8 offset0:4 offset1:5\n\tds_read2st64_b32 %3, %8 offset0:6 offset1:7\n\t"
                             "ds_read2st64_b32 %4, %8 offset0:8 offset1:9\n\tds_read2st64_b32 %5, %8 offset0:10 offset1:11\n\tds_read2st64_b32 %6, %8 offset0:12 offset1:13\n\tds_read2st64_b32 %7, %8 offset0:14 offset1:15\n\ts_waitcnt lgkmcnt(0)"
                             : "=&v"(*(f32x2_t*)&v[0]), "=&v"(*(f32x2_t*)&v[2]), "=&v"(*(f32x2_t*)&v[4]), "=&v"(*(f32x2_t*)&v[6]), "=&v"(*(f32x2_t*)&v[8]), "=&v"(*(f32x2_t*)&v[10]), "=&v"(*(f32x2_t*)&v[12]), "=&v"(*(f32x2_t*)&v[14])
                             : "v"(tpa) : "memory");
#pragma unroll
                for (int i = 0; i < 16; ++i) v[i] *= 32.0f;
                const u32x4 o = {pk4_fp8(v[0], v[1], v[2], v[3]), pk4_fp8(v[4], v[5], v[6], v[7]), pk4_fp8(v[8], v[9], v[10], v[11]), pk4_fp8(v[12], v[13], v[14], v[15])};
                *(u32x4*)(wc.ws + dofs + (size_t)(drow0 + lane) * 1024 + kb * 128 + wid * 16) = o;
            }
        }
        if (t + 2 < NT) ATT_DMA(t + 2, sl_nn);
        i32x8 pwa, pwc;
        { f32x16 pa0, pa1; ATT_QK(pa0, pa1, OFF_K1, qa); ATT_SM(pa0, pa1, l1, pwa); }
        asm volatile("" : "+v"(pwa), "+v"(l1));
        { f32x16 pc0, pc1; ATT_QK(pc0, pc1, OFF_K2, qc); ATT_SM(pc0, pc1, l2, pwc); }
#pragma unroll
        for (int db = 0; db < 4; ++db) {
            const i32x8 vf = ATT_FRAG(OFF_V + db * 2048);
            o1[db] = ATT_MMA_PV(pwa, vf, o1[db]);
            o2[db] = ATT_MMA_PV(pwc, vf, o2[db]);
        }
        asm volatile("" : "+v"(o1[0]), "+v"(o1[1]), "+v"(o1[2]), "+v"(o1[3]), "+v"(o2[0]), "+v"(o2[1]), "+v"(o2[2]), "+v"(o2[3]));
        sl_cur = (sl_cur == (NSLOT - 1) * SLOT) ? 0 : sl_cur + SLOT;
        sl_nn = (sl_nn == (NSLOT - 1) * SLOT) ? 0 : sl_nn + SLOT;
    }
#undef ATT_QK
#undef ATT_FRAG
#undef ATT_MMA_PV
#undef ATT_SM
    const int lane_e = opq_i(lane), r32e = lane_e & 31, hie = lane_e >> 5;
    { auto rr = __builtin_amdgcn_permlane32_swap(__float_as_uint(l1), __float_as_uint(l1), false, false); l1 = __uint_as_float(rr[0]) + __uint_as_float(rr[1]); }
    { auto rr = __builtin_amdgcn_permlane32_swap(__float_as_uint(l2), __float_as_uint(l2), false, false); l2 = __uint_as_float(rr[0]) + __uint_as_float(rr[1]); }
    __attribute__((address_space(3))) float* wsf = (__attribute__((address_space(3))) float*)(lds + OFF_WSF) + wid * 64;
    asm volatile("s_waitcnt lgkmcnt(0)\n\ts_barrier" ::: "memory");
    if (hie == 0) { wsf[r32e] = __builtin_amdgcn_rcpf(l1); wsf[32 + r32e] = lam * __builtin_amdgcn_rcpf(l2); }
    asm volatile("s_waitcnt lgkmcnt(0)" ::: "memory");
    float ss[16];
#pragma unroll
    for (int r = 0; r < 16; ++r) { const float c1 = wsf[crow(r, hie)], c2 = wsf[32 + crow(r, hie)]; float s = 0.f;
#pragma unroll
        for (int db = 0; db < 4; ++db) { const float val = o1[db][r] * c1 - o2[db][r] * c2; o1[db][r] = val; s += val * val; }
        s += __shfl_xor(s, 1); s += __shfl_xor(s, 2); s += __shfl_xor(s, 4); s += __shfl_xor(s, 8); s += __shfl_xor(s, 16);
        ss[r] = (1.0f - LAMBDA_INIT) / sqrtf(s * (1.0f / 128) + EPS); }
    __attribute__((address_space(3))) bf16* stg = (__attribute__((address_space(3))) bf16*)(lds + OFF_X) + wid * 4096;
#pragma unroll
    for (int db = 0; db < 4; ++db) { const float gg = subln[db * 32 + r32e];
#pragma unroll
        for (int r = 0; r < 16; ++r) stg[crow(r, hie) * 128 + db * 32 + r32e] = (bf16)f2bf(o1[db][r] * ss[r] * gg); }
    asm volatile("s_waitcnt lgkmcnt(0)" ::: "memory");
    bf16* Ow = attn_out + ((size_t)b * L + q0) * AW + h * VD;
#pragma unroll
    for (int i = 0; i < 8; ++i) { const int row = i * 4 + (lane_e >> 4), ch = lane_e & 15;
        const u32x4 val = *(const __attribute__((address_space(3))) u32x4*)(stg + row * 128 + ch * 8);
        *(u32x4*)(Ow + (size_t)row * AW + ch * 8) = val; }
    asm volatile("s_waitcnt lgkmcnt(0)\n\ts_barrier" ::: "memory");
#undef ATT_DMA
}
#undef ATT_WAIT_BAR
}
namespace hy {
typedef _Float16 f32x2 __attribute__((ext_vector_type(2)));
__device__ __forceinline__ f32x2 mkc(float re, float im) { return (f32x2){(_Float16)re, (_Float16)im}; }
typedef float f32x4v __attribute__((ext_vector_type(4)));
#define HLAS __attribute__((address_space(3)))
constexpr int N = 8192, OFF_BUF = 0, OFF_BUF1 = 34816, OFF_H1 = 69632, OFF_H2 = 69632 + 32832, HY_LDS_END = 69632 + 2 * 32832;
__device__ __forceinline__ int phys(int i) { return i + (i >> 5); }
__device__ __forceinline__ int opq(int x) { asm volatile("" : "+v"(x)); return x; }
__device__ __forceinline__ f32x2 cmul(f32x2 a, f32x2 b) { f32x2 r; asm("v_pk_mul_f16 %0, %1, %2 op_sel_hi:[1,0]\n\tv_pk_fma_f16 %0, %1, %2, %0 op_sel:[1,1,0] op_sel_hi:[0,1,1] neg_lo:[1,0,0]" : "=&v"(r) : "v"(a), "v"(b)); return r; }
__device__ __forceinline__ f32x2 cmulk(f32x2 a, f32x2 b) { const f32x2 axx = {a.x, a.x}, ayy = {a.y, a.y}, bs = {-b.y, b.x}; return __builtin_elementwise_fma(ayy, bs, axx * b); }
__device__ __forceinline__ f32x2 cmulc(f32x2 a, f32x2 b) { f32x2 r; asm("v_pk_mul_f16 %0, %1, %2 op_sel_hi:[1,0]\n\tv_pk_fma_f16 %0, %1, %2, %0 op_sel:[1,1,0] op_sel_hi:[0,1,1] neg_hi:[1,0,0]" : "=&v"(r) : "v"(a), "v"(b)); return r; }
__device__ __forceinline__ f32x2 cmul_cj(f32x2 a, f32x2 b) { f32x2 r; asm("v_pk_mul_f16 %0, %1, %2 op_sel_hi:[1,0]\n\tv_pk_fma_f16 %0, %1, %2, %0 op_sel:[1,1,0] op_sel_hi:[0,1,1] neg_lo:[1,0,0] neg_hi:[1,0,1]" : "=&v"(r) : "v"(a), "v"(b)); return r; }
__device__ __forceinline__ f32x2 cmulc_cj(f32x2 a, f32x2 b) { f32x2 r; asm("v_pk_mul_f16 %0, %1, %2 op_sel_hi:[1,0]\n\tv_pk_fma_f16 %0, %1, %2, %0 op_sel:[1,1,0] op_sel_hi:[0,1,1] neg_hi:[0,0,1]" : "=&v"(r) : "v"(a), "v"(b)); return r; }
__device__ __forceinline__ f32x2 twid(float frac) { return mkc(__builtin_amdgcn_cosf(frac), __builtin_amdgcn_sinf(frac)); }
__device__ __forceinline__ f32x2 mul_mi(f32x2 a) { return (f32x2){a.y, (_Float16)(-a.x)}; }
__device__ __forceinline__ f32x2 add_mi(f32x2 t, f32x2 d) { f32x2 r; asm("v_pk_add_f16 %0, %1, %2 op_sel:[0,1] op_sel_hi:[1,0] neg_hi:[0,1]" : "=v"(r) : "v"(t), "v"(d)); return r; }
__device__ __forceinline__ f32x2 sub_mi(f32x2 t, f32x2 d) { f32x2 r; asm("v_pk_add_f16 %0, %1, %2 op_sel:[0,1] op_sel_hi:[1,0] neg_lo:[0,1]" : "=v"(r) : "v"(t), "v"(d)); return r; }
#define HY_FFT4(a0, a1, a2, a3, r0, r1, r2, r3) do { const f32x2 t0_ = a0 + a2, t1_ = a0 - a2, t2_ = a1 + a3, d_ = a1 - a3; r0 = t0_ + t2_; r1 = add_mi(t1_, d_); r2 = t0_ - t2_; r3 = sub_mi(t1_, d_); } while (0)
#define HY_FFT4M(a0, a1, a2, a3, r0, r1, r2, r3) do { const f32x2 t0_ = add_mi(a0, a2), t1_ = sub_mi(a0, a2), t2_ = a1 + a3, d_ = a1 - a3; r0 = t0_ + t2_; r1 = add_mi(t1_, d_); r2 = t0_ - t2_; r3 = sub_mi(t1_, d_); } while (0)
__device__ __forceinline__ void fft16(const f32x2 (&u)[16], f32x2 (&v)[16]) {
    constexpr float C1 = 0.92387953251128674f, S1 = 0.38268343236508977f, R2 = 0.70710678118654752f;
    f32x2 y[16];
#pragma unroll
    for (int n1 = 0; n1 < 4; ++n1) HY_FFT4(u[n1], u[n1 + 4], u[n1 + 8], u[n1 + 12], y[n1], y[n1 + 4], y[n1 + 8], y[n1 + 12]);
    y[5] = cmulk(y[5], mkc(C1, -S1));  y[9] = cmulk(y[9], mkc(R2, -R2));   y[13] = cmulk(y[13], mkc(S1, -C1));
    y[6] = cmulk(y[6], mkc(R2, -R2));     y[14] = cmulk(y[14], mkc(-R2, -R2));
    y[7] = cmulk(y[7], mkc(S1, -C1));  y[11] = cmulk(y[11], mkc(-R2, -R2)); y[15] = cmulk(y[15], mkc(-C1, S1));
#pragma unroll
    for (int k2 = 0; k2 < 4; ++k2) { if (k2 == 2) HY_FFT4M(y[8], y[9], y[10], y[11], v[2], v[6], v[10], v[14]); else HY_FFT4(y[4 * k2], y[4 * k2 + 1], y[4 * k2 + 2], y[4 * k2 + 3], v[k2], v[4 + k2], v[8 + k2], v[12 + k2]); }
}
__device__ __forceinline__ void load16(const HLAS f32x2* buf, int tid, f32x2 (&u)[16]) {
    const HLAS f32x2* b = buf + phys(tid);
#pragma unroll
    for (int r = 0; r < 16; ++r) u[r] = b[528 * r];
}
template <int P> __device__ __forceinline__ void store16(HLAS f32x2* buf, int j, const f32x2 (&v)[16]) {
    HLAS f32x2* b = buf + phys(j);
#pragma unroll
    for (int r = 0; r < 16; ++r) b[P == 1 ? r : P == 16 ? 16 * r + (r >> 1) : 264 * r] = v[r];
}
struct Tw { f32x2 b[15], c[15], f[8]; };
__device__ __forceinline__ void tw_init(Tw& w, int tid) {
#pragma unroll
    for (int r = 1; r < 16; ++r) { w.b[r - 1] = twid(-(float)((tid & 15) * r) * (1.0f / 256.0f)); w.c[r - 1] = twid(-(float)((tid & 255) * r) * (1.0f / 4096.0f)); }
#pragma unroll
    for (int q = 0; q < 8; ++q) w.f[q] = twid(-(float)(tid + 512 * q) * (1.0f / 8192.0f));
}
__device__ __forceinline__ void twiddle16(f32x2 (&u)[16], const f32x2 (&w)[15]) {
#pragma unroll
    for (int r = 1; r < 16; ++r) u[r] = cmul(u[r], w[r - 1]);
}
__device__ __forceinline__ void passes_bc(HLAS f32x2* src, HLAS f32x2* dst, int tid_, const Tw& tw) {
    f32x2 u[16], v[16];
    int tid = opq(tid_);
    load16(src, tid, u);
    { const int k = tid & 15; twiddle16(u, tw.b); fft16(u, v); store16<16>(dst, (tid - k) * 16 + k, v); }
    __syncthreads();
    tid = opq(tid_);
    load16(dst, tid, u);
    { const int k = tid & 255; twiddle16(u, tw.c); fft16(u, v); store16<256>(src, (tid - k) * 16 + k, v); }
    __syncthreads();
}
__device__ __forceinline__ void fft_lds(HLAS f32x2* S, HLAS f32x2* D, int tid_, const Tw& tw) {
    int tid = opq(tid_);
    { f32x2 u[16], v[16]; load16(S, tid, u); fft16(u, v); store16<1>(D, tid * 16, v); }
    __syncthreads();
    passes_bc(D, S, tid_, tw);
    tid = opq(tid_);
    { HLAS f32x2* b = D + phys(tid);
    f32x2 a[8], c[8];
#pragma unroll
    for (int q = 0; q < 8; ++q) { a[q] = b[528 * q]; c[q] = b[528 * (q + 8)]; }
#pragma unroll
    for (int q = 0; q < 8; ++q) { c[q] = cmul(c[q], tw.f[q]); b[528 * q] = a[q] + c[q]; b[528 * (q + 8)] = a[q] - c[q]; } }
    __syncthreads();
}
__device__ __forceinline__ void conv_apply(HLAS f32x2* X, HLAS f32x2* Y, const HLAS f32x2* Hh, int tid, const Tw& tw, const f32x2 (&zin)[8], f32x2 (&yout)[8]) {
    const int tid_ = tid;
    tid = opq(tid_);
    { f32x2 u[16], v[16];
#pragma unroll
      for (int r = 0; r < 8; ++r) { u[r] = zin[r]; u[r + 8] = mkc(0.f, 0.f); }
      fft16(u, v); store16<1>(X, tid * 16, v); }
    __syncthreads();
    passes_bc(X, Y, tid_, tw);
    tid = opq(tid_);
    { const HLAS f32x2* b = X + phys(tid); const HLAS f32x2* ha = Hh + tid; const HLAS f32x2* hb = Hh + (4096 - 512 * 7) - tid;
    f32x2 a[8], c[8], h0[8], h1[8], u[16], v[16];
#pragma unroll
    for (int q = 0; q < 8; ++q) { a[q] = b[528 * q]; c[q] = b[528 * (q + 8)]; h0[q] = ha[512 * q]; h1[q] = hb[512 * (7 - q)]; }
#pragma unroll
    for (int q = 0; q < 8; ++q) { c[q] = cmul(c[q], tw.f[q]);
        const f32x2 d0 = a[q] + c[q], d1 = a[q] - c[q];
        u[q] = cmul_cj(d0, h0[q]); u[q + 8] = cmulc_cj(d1, h1[q]); }
    fft16(u, v); store16<1>(Y, tid * 16, v); }
    __syncthreads();
    passes_bc(Y, X, tid_, tw);
    tid = opq(tid_);
    { const HLAS f32x2* b = Y + phys(tid);
#pragma unroll
    for (int q = 0; q < 8; ++q) { const f32x2 a = b[528 * q], c = cmul(b[528 * (q + 8)], tw.f[q]);
        yout[q] = (a + c) * mkc(1.0f / 64.0f, -1.0f / 64.0f); } }
}
typedef unsigned u32x4s __attribute__((ext_vector_type(4)));
struct RowPair { u32x4s a, b; };
__device__ __forceinline__ RowPair rows_load(const bf16* r0, const bf16* r1, int tid) { RowPair r; r.a = __builtin_nontemporal_load((const u32x4s*)r0 + tid); r.b = __builtin_nontemporal_load((const u32x4s*)r1 + tid); return r; }
__device__ __forceinline__ void sconv_pair(const RowPair& rp, HLAS unsigned* stg, int tid, f32x2 w0, f32x2 w1, f32x2 w2, f32x2 bias, f32x2 (&o)[8]) {
    u32x4s d0, d1;
#pragma unroll
    for (int i = 0; i < 4; ++i) { const unsigned lo = __builtin_bit_cast(unsigned, mkc(bflo(rp.a[i]), bflo(rp.b[i]))), hi = __builtin_bit_cast(unsigned, mkc(bfhi(rp.a[i]), bfhi(rp.b[i])));
        if (i < 2) { d0[2 * i] = lo; d0[2 * i + 1] = hi; } else { d1[2 * i - 4] = lo; d1[2 * i - 3] = hi; } }
    ((HLAS u32x4s*)stg)[2 + 2 * tid] = d0;
    ((HLAS u32x4s*)stg)[3 + 2 * tid] = d1;
    if (tid == 0) { stg[7] = 0u; stg[8 + 4096] = 0u; }
    __syncthreads();
    const unsigned xa = (unsigned)(uintptr_t)(stg + 7 + tid);
#pragma unroll
    for (int hq = 0; hq < 2; ++hq) {
        unsigned v[12];
        if (hq == 0) asm volatile("ds_read_b32 %0, %12 offset:0\n\tds_read_b32 %1, %12 offset:4\n\tds_read_b32 %2, %12 offset:8\n\tds_read_b32 %3, %12 offset:2048\n\tds_read_b32 %4, %12 offset:2052\n\tds_read_b32 %5, %12 offset:2056\n\tds_read_b32 %6, %12 offset:4096\n\tds_read_b32 %7, %12 offset:4100\n\tds_read_b32 %8, %12 offset:4104\n\tds_read_b32 %9, %12 offset:6144\n\tds_read_b32 %10, %12 offset:6148\n\tds_read_b32 %11, %12 offset:6152\n\ts_waitcnt lgkmcnt(0)" : "=&v"(v[0]), "=&v"(v[1]), "=&v"(v[2]), "=&v"(v[3]), "=&v"(v[4]), "=&v"(v[5]), "=&v"(v[6]), "=&v"(v[7]), "=&v"(v[8]), "=&v"(v[9]), "=&v"(v[10]), "=&v"(v[11]) : "v"(xa) : "memory");
        else asm volatile("ds_read_b32 %0, %12 offset:8192\n\tds_read_b32 %1, %12 offset:8196\n\tds_read_b32 %2, %12 offset:8200\n\tds_read_b32 %3, %12 offset:10240\n\tds_read_b32 %4, %12 offset:10244\n\tds_read_b32 %5, %12 offset:10248\n\tds_read_b32 %6, %12 offset:12288\n\tds_read_b32 %7, %12 offset:12292\n\tds_read_b32 %8, %12 offset:12296\n\tds_read_b32 %9, %12 offset:14336\n\tds_read_b32 %10, %12 offset:14340\n\tds_read_b32 %11, %12 offset:14344\n\ts_waitcnt lgkmcnt(0)" : "=&v"(v[0]), "=&v"(v[1]), "=&v"(v[2]), "=&v"(v[3]), "=&v"(v[4]), "=&v"(v[5]), "=&v"(v[6]), "=&v"(v[7]), "=&v"(v[8]), "=&v"(v[9]), "=&v"(v[10]), "=&v"(v[11]) : "v"(xa) : "memory");
#pragma unroll
        for (int j = 0; j < 4; ++j) { const f32x2 xm = __builtin_bit_cast(f32x2, v[3 * j]), x0 = __builtin_bit_cast(f32x2, v[3 * j + 1]), xp = __builtin_bit_cast(f32x2, v[3 * j + 2]);
            o[hq * 4 + j] = __builtin_elementwise_fma(xp, w2, __builtin_elementwise_fma(xm, w0, __builtin_elementwise_fma(x0, w1, bias))); }
    }
}
__device__ __forceinline__ void hyena_channel(const P& p, int c, HLAS unsigned char* lds, int tid_, const Tw& tw) {
    int tid = opq(tid_);
    HLAS f32x2* buf = (HLAS f32x2*)(lds + OFF_BUF); HLAS f32x2* H1 = (HLAS f32x2*)(lds + OFF_H1); HLAS f32x2* H2 = (HLAS f32x2*)(lds + OFF_H2);
    const float* hid3 = (const float*)(p.ws + WS_HID3);
    const bf16* hyT = (const bf16*)(p.ws + WS_HYT); bf16* hyo = (bf16*)(p.ws + WS_HYT2);
    __syncthreads();
    {
        const _Float16* ft = (const _Float16*)(p.ws + WS_FILT) + (size_t)c * L;
#pragma unroll
        for (int q = 0; q < 8; ++q) { const int l = tid + 512 * q;
            const _Float16 f0 = __builtin_nontemporal_load(ft + l), f1 = __builtin_nontemporal_load(ft + (size_t)512 * L + l), f2 = __builtin_nontemporal_load(ft + (size_t)1024 * L + l), f3 = __builtin_nontemporal_load(ft + (size_t)1536 * L + l);
            buf[phys(l)] = (f32x2){f0, f2};
            if (l >= 1) buf[phys(N - l)] = (f32x2){f1, f3}; }
        if (tid == 0) buf[phys(4096)] = mkc(0.f, 0.f);
    }
    RowPair rz = rows_load(hyT + ((size_t)0 * HYC + c) * L, hyT + ((size_t)1 * HYC + c) * L, tid);
    __syncthreads();
    HLAS f32x2* buf1 = (HLAS f32x2*)(lds + OFF_BUF1);
    fft_lds(buf, buf1, tid_, tw);
    tid = opq(tid_);
#pragma unroll
    for (int q = 0; q < 8; ++q) { const int k = tid + 512 * q; const f32x2 wk = buf1[phys(k)], wn = buf1[phys((N - k) & (N - 1))];
        const float s = 0.5f / 2048.0f;
        H1[k] = mkc(((float)wk.x + (float)wn.x) * s, ((float)wk.y - (float)wn.y) * s);
        H2[k] = mkc(((float)wk.y + (float)wn.y) * s, ((float)wn.x - (float)wk.x) * s); }
    if (tid == 0) { const f32x2 wk = buf1[phys(4096)]; H1[4096] = mkc((float)wk.x * (1.0f / 2048.0f), 0.f); H2[4096] = mkc((float)wk.y * (1.0f / 2048.0f), 0.f); }
    const f32x2 w0z = mkc(p.scw[c], p.scw[c]), w1z = mkc(p.scw[HYC + c], p.scw[HYC + c]), w2z = mkc(p.scw[2 * HYC + c], p.scw[2 * HYC + c]), bz = mkc(p.scb[c], p.scb[c]);
    const f32x2 w0a = mkc(p.scw[512 + c], p.scw[512 + c]), w1a = mkc(p.scw[HYC + 512 + c], p.scw[HYC + 512 + c]), w2a = mkc(p.scw[2 * HYC + 512 + c], p.scw[2 * HYC + 512 + c]), ba = mkc(p.scb[512 + c], p.scb[512 + c]);
    const f32x2 w0b = mkc(p.scw[1024 + c], p.scw[1024 + c]), w1b = mkc(p.scw[HYC + 1024 + c], p.scw[HYC + 1024 + c]), w2b = mkc(p.scw[2 * HYC + 1024 + c], p.scw[2 * HYC + 1024 + c]), bb = mkc(p.scb[1024 + c], p.scb[1024 + c]);
    const f32x2 sk1 = mkc(p.hskip[c], p.hskip[c]), sk2 = mkc(p.hskip[512 + c], p.hskip[512 + c]);
    int sb = 0;
#define HY_B(i) ((HLAS f32x2*)(lds + OFF_BUF + (i) * OFF_BUF1))
#pragma unroll 1
    for (int pp = 0; pp < 2; ++pp) {
        const int b0 = 2 * pp, b1 = 2 * pp + 1;
        const bf16* z0p = hyT + ((size_t)b0 * HYC + c) * L; const bf16* z1p = hyT + ((size_t)b1 * HYC + c) * L;
        f32x2 zz[8], yy[8], gg[8];
        tid = opq(tid_);
        sconv_pair(rz, (HLAS unsigned*)HY_B(sb), tid, w0z, w1z, w2z, bz, zz);
        RowPair rg = rows_load(z0p + (size_t)512 * L, z1p + (size_t)512 * L, tid);
        conv_apply(HY_B(sb ^ 1), HY_B(sb), H1, tid_, tw, zz, yy);
        sb ^= 1;
        tid = opq(tid_);
        sconv_pair(rg, (HLAS unsigned*)HY_B(sb), tid, w0a, w1a, w2a, ba, gg);
#pragma unroll
        for (int q = 0; q < 8; ++q) zz[q] = gg[q] * __builtin_elementwise_fma(sk1, zz[q], yy[q]);
        rg = rows_load(z0p + (size_t)1024 * L, z1p + (size_t)1024 * L, tid);
        { const int nb = (pp == 0) ? 2 : 0; rz = rows_load(hyT + ((size_t)nb * HYC + c) * L, hyT + ((size_t)(nb + 1) * HYC + c) * L, tid); }
        conv_apply(HY_B(sb ^ 1), HY_B(sb), H2, tid_, tw, zz, yy);
        sb ^= 1;
        tid = opq(tid_);
        sconv_pair(rg, (HLAS unsigned*)HY_B(sb), tid, w0b, w1b, w2b, bb, gg);
        sb ^= 1;
#pragma unroll
        for (int q = 0; q < 8; ++q) { const int l = tid + 512 * q; const f32x2 o = gg[q] * __builtin_elementwise_fma(sk2, zz[q], yy[q]);
            hyo[((size_t)b0 * HW + c) * L + l] = (bf16)f2bf((float)o.x); hyo[((size_t)b1 * HW + c) * L + l] = (bf16)f2bf((float)o.y); }
    }
#undef HY_B
    __syncthreads();
}
#undef HLAS
}
#define LAS __attribute__((address_space(3)))
constexpr int NWAVES = 8, NTHR = 512;
constexpr int RING_BYTES = 131072, LDS_BYTES = 147456;
#define LDS_WAIT() asm volatile("s_waitcnt lgkmcnt(0)" ::: "memory")
constexpr int MISC_OFF = LDS_BYTES - 256;
constexpr int CW_BAR = 4096;
#define GAS __attribute__((address_space(1)))
typedef unsigned v4u __attribute__((ext_vector_type(4)));
typedef GAS unsigned gu32;
typedef GAS unsigned long long gu64;
#define RLX_AGENT __ATOMIC_RELAXED, __HIP_MEMORY_SCOPE_AGENT
#define VM_WAIT() asm volatile("s_waitcnt vmcnt(0)" ::: "memory")
__device__ __forceinline__ unsigned long long rt() { return __builtin_amdgcn_s_memrealtime(); }

#define XB_TMO      128
#define XB_XCNT(j)  (256  + 64 * (j))
#define XB_XSUB(j)  (1280 + 64 * (j))
#define XB_XGEN(j)  (2304 + 64 * (j))
#define XB_TOP      3328
#define XB_TOPGEN   3392
#define XCD_BAR_WORDS 3456
#define XB_SPIN_CAP (1u << 18)

__device__ __forceinline__ unsigned xb_ld(unsigned* p)              { return __hip_atomic_load(p, __ATOMIC_RELAXED, __HIP_MEMORY_SCOPE_AGENT); }
__device__ __forceinline__ unsigned xb_add(unsigned* p, unsigned v) { return __hip_atomic_fetch_add(p, v, __ATOMIC_RELAXED, __HIP_MEMORY_SCOPE_AGENT); }
__device__ __forceinline__ unsigned xb_xcc_id() { return (unsigned)__builtin_amdgcn_s_getreg((3 << 11) | 20) & 0xFu; }
#define XB_SPIN(cond, bar) do { unsigned _sp = 0; while (cond) { __builtin_amdgcn_s_sleep(1); \
    if ((++_sp & 255u) == 0u) { if (xb_ld(&(bar)[XB_TMO])) break; if (_sp > XB_SPIN_CAP) { atomicAdd(&(bar)[XB_TMO], 1u); break; } } } } while (0)

struct XcdBarrier {
    unsigned* bar; unsigned x;
    volatile LAS unsigned* st;
};

__device__ __forceinline__ XcdBarrier xcd_barrier_post(unsigned* bar, volatile LAS unsigned* st) {
    XcdBarrier b; b.bar = bar; b.x = xb_xcc_id(); b.st = st;
    if (threadIdx.x == 0) (void)xb_add(&bar[XB_XCNT(b.x)], 1u);
    return b;
}
__device__ __forceinline__ void xcd_barrier_complete(unsigned* bar, unsigned x, unsigned& nloc, unsigned& nx) {
    const unsigned G = gridDim.x * gridDim.y * gridDim.z;
    unsigned sum, cnt, mine, sp = 0u;
    for (;;) {
        sum = 0u; cnt = 0u; mine = 0u;
#pragma unroll
        for (unsigned j = 0; j < 16; ++j) { const unsigned c = xb_ld(&bar[XB_XCNT(j)]); sum += c; cnt += (c > 0u) ? 1u : 0u; mine = (j == x) ? c : mine; }
        if (sum == G) break;
        __builtin_amdgcn_s_sleep(1);
        if ((++sp & 255u) == 0u) { if (xb_ld(&bar[XB_TMO])) break; if (sp > XB_SPIN_CAP) { atomicAdd(&bar[XB_TMO], 1u); break; } }
    }
    nloc = mine > 0u ? mine : 1u; nx = cnt > 0u ? cnt : 1u;
}

template <bool FENCE = true, bool FACQ = FENCE, bool PRE = true> __device__ __forceinline__ void xcd_barrier(const XcdBarrier& b) {
    if (PRE) {
    asm volatile("s_waitcnt vmcnt(0)" ::: "memory");
    __syncthreads();
    }
    if (threadIdx.x == 0) {
        unsigned* bar = b.bar;
        __builtin_amdgcn_s_waitcnt(0);
        unsigned nloc = b.st[0], nx = b.st[1];
        if (nloc == 0u) { xcd_barrier_complete(bar, b.x, nloc, nx); b.st[0] = nloc; b.st[1] = nx; }
        const unsigned old = xb_add(&bar[XB_XSUB(b.x)], 1u);
        const unsigned gen = old / nloc;
        if (old + 1u == (gen + 1u) * nloc) {
            if (FENCE) __builtin_amdgcn_fence(__ATOMIC_RELEASE, "agent");
            asm volatile("s_waitcnt vmcnt(0)" ::: "memory");
            const unsigned og = xb_add(&bar[XB_TOP], 1u);
            const unsigned tg = og / nx;
            if (og + 1u == (tg + 1u) * nx) xb_add(&bar[XB_TOPGEN], 1u);
            else XB_SPIN(xb_ld(&bar[XB_TOPGEN]) == tg, bar);
            if (FACQ) __builtin_amdgcn_fence(__ATOMIC_ACQUIRE, "agent");
            xb_add(&bar[XB_XGEN(b.x)], 1u);
            asm volatile("s_waitcnt vmcnt(0)" ::: "memory");
        } else {
            XB_SPIN(xb_ld(&bar[XB_XGEN(b.x)]) == gen, bar);
            if (FACQ) asm volatile("s_waitcnt vmcnt(0)\n\tbuffer_inv sc0" ::: "memory");
            asm volatile("s_waitcnt vmcnt(0)" ::: "memory");
        }
    }
    __syncthreads();
}

__device__ __forceinline__ void panel_rendezvous(const XcdBarrier& b, unsigned* pc) {
    asm volatile("s_waitcnt vmcnt(0)" ::: "memory");
    __syncthreads();
    if (threadIdx.x == 0) {
        const unsigned x = b.x, sh = 8u + 3u * (x & 7u);
        __builtin_amdgcn_s_waitcnt(0);
        (void)xb_add(pc, 1u + ((x < 8u) ? (1u << sh) : 0u));
        XB_SPIN((xb_ld(pc) & 0xffu) < 4u, b.bar);
        const unsigned v = xb_ld(pc);
        if (x >= 8u || ((v >> sh) & 7u) != 4u) {
            __builtin_amdgcn_fence(__ATOMIC_RELEASE, "agent");
            asm volatile("s_waitcnt vmcnt(0)" ::: "memory");
            (void)xb_add(pc + 1024, 1u);
            XB_SPIN(xb_ld(pc + 1024) < 4u, b.bar);
            __builtin_amdgcn_fence(__ATOMIC_ACQUIRE, "agent");
        } else asm volatile("s_waitcnt vmcnt(0)\n\tbuffer_inv sc0" ::: "memory");
        asm volatile("s_waitcnt vmcnt(0)" ::: "memory");
    }
    __syncthreads();
}

__device__ __forceinline__ int colmap_in(int R) {
    if (R >= 3584) return 1536 + (R - 3584);
    const int pn = R >> 8, rt = R & 255;
    if (pn < 4) { const int bj = rt >> 7, wc = (rt >> 5) & 3, i = rt & 31, gidx = pn * 4 + wc;
        const int d = (bj == 0 && i < 16) ? (4 * (i >> 3) + ((i & 7) >> 1) + 8 * (i & 1)) : (32 * bj + i);
        return gidx * 64 + d; }
    if (pn < 6) return 1024 + (pn - 4) * 256 + rt;
    return 3072 + (pn - 6) * 256 + rt;
}
__device__ __forceinline__ void transpose_item(const float* W, int N, int K, bf16* WT, int k0, int drow0, int scol, const float* kscale, LAS float* scr, int lane) {
#pragma unroll
    for (int i = 0; i < 32; ++i) { const int kk = 2 * i + (lane >> 5); scr[kk * 33 + (lane & 31)] = __builtin_nontemporal_load(W + (size_t)(k0 + kk) * N + scol); }
    const int c = lane & 7;
    pg8::f32x4 ks0 = {1.f, 1.f, 1.f, 1.f}, ks1 = {1.f, 1.f, 1.f, 1.f};
    if (kscale) { ks0 = *(const pg8::f32x4*)(kscale + k0 + 8 * c); ks1 = *(const pg8::f32x4*)(kscale + k0 + 8 * c + 4); }
    LDS_WAIT(); asm volatile("" ::: "memory");
#pragma unroll
    for (int j = 0; j < 4; ++j) { const int n = (lane >> 3) + 8 * j; const LAS float* s = scr + (8 * c) * 33 + n;
        uint4 o; o.x = pk2(s[0 * 33] * ks0[0], s[1 * 33] * ks0[1]); o.y = pk2(s[2 * 33] * ks0[2], s[3 * 33] * ks0[3]); o.z = pk2(s[4 * 33] * ks1[0], s[5 * 33] * ks1[1]); o.w = pk2(s[6 * 33] * ks1[2], s[7 * 33] * ks1[3]);
        *(uint4*)(WT + (size_t)(drow0 + n) * K + k0 + 8 * c) = o; }
    LDS_WAIT(); asm volatile("" ::: "memory");
}
__device__ __forceinline__ void transpose_item_fp8(const float* W, int N, int K, unsigned char* WT, int k0, int drow0, int scol, float mul, LAS float* scr, int lane) {
#pragma unroll
    for (int i = 0; i < 32; ++i) { const int kk = 2 * i + (lane >> 5); scr[kk * 33 + (lane & 31)] = __builtin_nontemporal_load(W + (size_t)(k0 + kk) * N + scol) * mul; }
    LDS_WAIT(); asm volatile("" ::: "memory");
    const int c = lane & 7;
#pragma unroll
    for (int j = 0; j < 4; ++j) { const int n = (lane >> 3) + 8 * j; const LAS float* s = scr + (8 * c) * 33 + n;
        uint2 o; o.x = pk4_fp8(s[0 * 33], s[1 * 33], s[2 * 33], s[3 * 33]); o.y = pk4_fp8(s[4 * 33], s[5 * 33], s[6 * 33], s[7 * 33]);
        *(uint2*)(WT + (size_t)(drow0 + n) * K + k0 + 8 * c) = o; }
    LDS_WAIT(); asm volatile("" ::: "memory");
}
__device__ __forceinline__ void p0_prologue(const P& p, LAS unsigned char* lds, int gw, int NGW, int wave, int lane, int gt, int NGT, int mask) {
    LAS float* scr = (LAS float*)(lds + wave * 16384);
    unsigned char* ws = p.ws;
    constexpr int I_IN = 16 * 160, I_PA = 8 * 32, I_O = 16 * 32, NITEMS = I_IN + 2 * I_PA + I_O;
    if (mask & 1)
    for (int it = gw; it < NITEMS; it += NGW) {
        int r = it;
        if (r < I_IN) { const int kb = r / 160, nb = r % 160; transpose_item(p.w_in, INC, D, (bf16*)(ws + WS_WINT), kb * 64, nb * 32, colmap_in(nb * 32 + (lane & 31)), p.norm1_g, scr, lane); continue; } r -= I_IN;
        if (r < I_PA) { const int kb = r / 32, nb = r % 32; transpose_item(p.wpa, D, 512, (bf16*)(ws + WS_WPA), kb * 64, nb * 32, nb * 32 + (lane & 31), nullptr, scr, lane); continue; } r -= I_PA;
        if (r < I_PA) { const int kb = r / 32, nb = r % 32; transpose_item(p.wph, D, 512, (bf16*)(ws + WS_WPH), kb * 64, nb * 32, nb * 32 + (lane & 31), nullptr, scr, lane); continue; } r -= I_PA;
        { const int kb = r / 32, nb = r % 32; transpose_item(p.wo, D, D, (bf16*)(ws + WS_WO), kb * 64, nb * 32, nb * 32 + (lane & 31), nullptr, scr, lane); }
    }
    float* rstd1 = (float*)(ws + WS_RSTD1); bf16* xb = (bf16*)(ws + WS_XB);
    if (mask & 2)
    for (int t0 = gw * 8; t0 < T; t0 += NGW * 8) {
        float4 v[8][4];
#pragma unroll
        for (int r = 0; r < 8; ++r)
#pragma unroll
            for (int j = 0; j < 4; ++j) { const pg8::f32x4 t_ = __builtin_nontemporal_load((const pg8::f32x4*)(p.x + (size_t)(t0 + r) * D) + lane + 64 * j); v[r][j] = make_float4(t_[0], t_[1], t_[2], t_[3]); }
#pragma unroll
        for (int r = 0; r < 8; ++r) { float s = 0.f;
#pragma unroll
            for (int j = 0; j < 4; ++j) { const float4 q = v[r][j]; s += q.x * q.x + q.y * q.y + q.z * q.z + q.w * q.w;
                uint2 pk; pk.x = pk2(q.x, q.y); pk.y = pk2(q.z, q.w); ((uint2*)(xb + (size_t)(t0 + r) * D))[lane + 64 * j] = pk; }
            s = wave_sum(s);
            if (lane == 0) rstd1[t0 + r] = __builtin_amdgcn_rsqf(s * (1.0f / D) + EPS); }
    }
    float* rc = (float*)(ws + WS_ROPE); float* rs = rc + L * 8;
    if (mask & 4) {
        constexpr double INVF[8] = {1.0, 0.19392274474868576, 0.03760603093086393, 0.007292664737217109, 0.001414213562373095, 0.0002742481756762073, 5.318295896944988e-05, 1.031338537721246e-05};
        if ((gt & 3) == 0 && (gt >> 2) < L * 8) { const int i = gt >> 2, l = i >> 3, j = i & 7;
            double invf = INVF[0];
#pragma unroll
            for (int q = 1; q < 8; ++q) invf = (j == q) ? INVF[q] : invf;
            const double ang = (double)l * invf, rr = ang - 6.283185307179586476925 * rint(ang * 0.15915494309189533577);
            const float rf = (float)rr;
            rc[i] = cosf(rf); rs[i] = sinf(rf); }
    }
    float* hid3 = (float*)(ws + WS_HID3);
    if (mask & 8)
    for (int l = gw; l < L; l += NGW) {
        const float t = (float)l / (float)(L - 1);
        const float fr = p.ffreq[lane];
        float a = p.fb1[lane] + t * p.fw1[lane];
        float csv;
        { const int j = lane & 15;
          const float band = 1e-4f + (float)j * ((15.0f - 1e-4f) / 15.0f);
          const float ang = (2.0f * 3.14159265358979323846f / (float)L) * (float)l * band;
          csv = (lane & 16) ? sinf(ang) : cosf(ang); }
#pragma unroll
        for (int j = 0; j < 16; ++j)
            a += __shfl(csv, j) * p.fw1[(1 + j) * 64 + lane] - __shfl(csv, 16 + j) * p.fw1[(17 + j) * 64 + lane];
        float h = sinf(fr * a);
        float a2 = p.fb2[lane];
        for (int i = 0; i < 64; ++i) a2 += __shfl(h, i) * p.fw2[i * 64 + lane];
        h = sinf(fr * a2);
        float a3 = p.fb3[lane];
        for (int i = 0; i < 64; ++i) a3 += __shfl(h, i) * p.fw3[i * 64 + lane];
        hid3[(size_t)lane * L + l] = sinf(fr * a3);
    }
}

typedef short tap_bf16x8 __attribute__((ext_vector_type(8)));
__device__ __forceinline__ void tap_split(const float (&v)[8], tap_bf16x8& hi, tap_bf16x8& lo) {
    unsigned h[4], l[4];
#pragma unroll
    for (int i = 0; i < 4; ++i) { h[i] = pk2(v[2 * i], v[2 * i + 1]); l[i] = pk2(v[2 * i] - bflo(h[i]), v[2 * i + 1] - bfhi(h[i])); }
    const pg8::u32x4 hv = {h[0], h[1], h[2], h[3]}, lv = {l[0], l[1], l[2], l[3]};
    hi = __builtin_bit_cast(tap_bf16x8, hv); lo = __builtin_bit_cast(tap_bf16x8, lv);
}
__device__ __forceinline__ void p1_filter_taps(const P& p, int gw, int NGW, int lane) {
    typedef float f32x16 __attribute__((ext_vector_type(16)));
    const float* hid3 = (const float*)(p.ws + WS_HID3); _Float16* ft = (_Float16*)(p.ws + WS_FILT);
    const float mind = logf(1e-2f) / 1.5f, maxd = logf(1e-2f) / 0.3f;
    const int r32 = lane & 31, hi = lane >> 5;
    for (int task = gw; task < 128 * 16; task += NGW) {
        const int l0 = (task & 127) * 32, cg = task >> 7, l = l0 + r32;
        float raw[4][8], an[4][8];
        const unsigned lo_h = (unsigned)opq_i(8 * hi * L + l), lo_w = (unsigned)opq_i(8 * hi * 2048 + r32);
        tap_bf16x8 bh[4], bl[4], ah[4], al[4];
#pragma unroll
        for (int j = 0; j < 4; ++j)
#pragma unroll
            for (int i = 0; i < 8; ++i) raw[j][i] = (hid3 + (size_t)(16 * j + i) * L)[lo_h];
#pragma unroll
        for (int j = 0; j < 4; ++j)
#pragma unroll
            for (int i = 0; i < 8; ++i) an[j][i] = (p.fwo + (size_t)(16 * j + i) * 2048 + cg * 128)[lo_w];
#pragma unroll
        for (int j = 0; j < 4; ++j) tap_split(raw[j], bh[j], bl[j]);
        const float tl2 = ((float)l / (float)(L - 1)) * 1.4426950408889634f;
#pragma unroll
        for (int ct = 0; ct < 4; ++ct) {
            const int col0 = cg * 128 + ct * 32;
#pragma unroll
            for (int j = 0; j < 4; ++j) tap_split(an[j], ah[j], al[j]);
            asm volatile("" ::: "memory");
            if (ct < 3) {
#pragma unroll
                for (int j = 0; j < 4; ++j)
#pragma unroll
                    for (int i = 0; i < 8; ++i) an[j][i] = (p.fwo + (size_t)(16 * j + i) * 2048 + col0 + 32)[lo_w];
            }
            f32x16 acc = f32x16{};
#pragma unroll
            for (int j = 0; j < 4; ++j) {
                acc = __builtin_amdgcn_mfma_f32_32x32x16_bf16(al[j], bh[j], acc, 0, 0, 0);
                acc = __builtin_amdgcn_mfma_f32_32x32x16_bf16(ah[j], bl[j], acc, 0, 0, 0);
                acc = __builtin_amdgcn_mfma_f32_32x32x16_bf16(ah[j], bh[j], acc, 0, 0, 0); }
#pragma unroll
            for (int r = 0; r < 16; ++r) { const int col = col0 + (r & 3) + 8 * (r >> 2) + 4 * hi;
                const float delta = fabsf(mind + ((maxd - mind) * (1.0f / 511.0f)) * (float)(col & 511));
                ft[(size_t)col * L + l] = (_Float16)(16.0f * acc[r] * __builtin_amdgcn_exp2f(-tl2 * delta)); }
        }
    }
}

__device__ __forceinline__ void p3_transpose_panel(const P& p, LAS unsigned char* lds, int pm, int pn, int wave, int lane) {
    typedef short v4i16_t __attribute__((ext_vector_type(4)));
    const int t0 = pm * 256, b = t0 / L, l0 = t0 % L;
    const bf16* src = (const bf16*)(p.ws + WS_HYT2) + ((size_t)b * HW) * L + l0; bf16* dst = (bf16*)(p.ws + WS_HYENA) + (size_t)t0 * HW;
    LAS unsigned char* img = lds + wave * 9216;
    const int g = lane >> 4, i = lane & 15, q = i >> 2, pq = i & 3;
    {
        const int c0 = wave * 64, k0 = pn * 64;
        pg8::u32x4 v[8];
#pragma unroll
        for (int j = 0; j < 8; ++j) v[j] = *(const pg8::u32x4*)(src + (size_t)(c0 + (lane >> 3) + 8 * j) * L + k0 + (lane & 7) * 8);
#pragma unroll
        for (int j = 0; j < 8; ++j) *(LAS pg8::u32x4*)(img + ((lane >> 3) + 8 * j) * 144 + (lane & 7) * 16) = v[j];
        LDS_WAIT(); asm volatile("" ::: "memory");
#pragma unroll
        for (int k = 0; k < 8; ++k) {
            const int ch = 8 * (4 * (k & 1) + g), tk = 16 * (k >> 1);
            const LAS unsigned char* a0 = img + (ch + q) * 144 + (tk + 4 * pq) * 2;
            const v4i16_t lo = __builtin_amdgcn_ds_read_tr16_b64_v4i16((LAS v4i16_t*)a0), hi = __builtin_amdgcn_ds_read_tr16_b64_v4i16((LAS v4i16_t*)(a0 + 4 * 144));
            pg8::u32x4 o; o.x = (unsigned short)lo[0] | ((unsigned)(unsigned short)lo[1] << 16); o.y = (unsigned short)lo[2] | ((unsigned)(unsigned short)lo[3] << 16);
            o.z = (unsigned short)hi[0] | ((unsigned)(unsigned short)hi[1] << 16); o.w = (unsigned short)hi[2] | ((unsigned)(unsigned short)hi[3] << 16);
            *(pg8::u32x4*)(dst + (size_t)(k0 + tk + i) * HW + c0 + ch) = o;
        }
        LDS_WAIT(); asm volatile("" ::: "memory");
    }
}

__device__ __forceinline__ void p5_router(const P& p, LAS unsigned char* lds, int gw, int NGW, int tid, int lane) {
    LAS float* wrT = (LAS float*)lds;
    float* aff = (float*)(p.ws + WS_AFF); unsigned char* u2 = (unsigned char*)(p.ws + WS_U2);
    constexpr int RPW = 8;
    pg8::f32x4 rows[RPW][4];
#pragma unroll
    for (int i = 0; i < RPW; ++i)
#pragma unroll
        for (int j = 0; j < 4; ++j) rows[i][j] = ((const pg8::f32x4*)(p.out + (size_t)(gw + i * NGW) * D))[lane + 64 * j];
    for (int i = tid; i < D * NE; i += NTHR) { const int d = i >> 4, e = i & 15; wrT[e * (D + 4) + d] = p.wr[i]; }
    pg8::f32x4 g4[4];
#pragma unroll
    for (int j = 0; j < 4; ++j) g4[j] = ((const pg8::f32x4*)p.norm2_g)[lane + 64 * j];
    __syncthreads();
    constexpr int RG = 4;
#pragma unroll
    for (int ig = 0; ig < RPW; ig += RG) {
#pragma unroll
        for (int r = 0; r < RG; ++r) {
            const int i = ig + r, t = gw + i * NGW; float s = 0.f;
#pragma unroll
            for (int j = 0; j < 4; ++j) { const pg8::f32x4 u = rows[i][j]; s += u[0] * u[0] + u[1] * u[1] + u[2] * u[2] + u[3] * u[3]; }
            const float rs = __builtin_amdgcn_rsqf(wave_sum(s) * (1.0f / D) + EPS);
#pragma unroll
            for (int j = 0; j < 4; ++j) {
                rows[i][j] = rows[i][j] * g4[j] * rs;
                ((unsigned*)(u2 + (size_t)t * D))[lane + 64 * j] = pk4_fp8(rows[i][j][0], rows[i][j][1], rows[i][j][2], rows[i][j][3]);
            }
        }
        float pa[RG][NE];
#pragma unroll
        for (int e = 0; e < NE; ++e) {
            pg8::f32x4 w[4];
#pragma unroll
            for (int j = 0; j < 4; ++j) w[j] = ((const LAS pg8::f32x4*)(wrT + e * (D + 4)))[lane + 64 * j];
#pragma unroll
            for (int r = 0; r < RG; ++r) {
                float a = 0.f;
#pragma unroll
                for (int j = 0; j < 4; ++j) { const pg8::f32x4 u = rows[ig + r][j]; a += u[0] * w[j][0] + u[1] * w[j][1] + u[2] * w[j][2] + u[3] * w[j][3]; }
                pa[r][e] = a;
                asm volatile("" : "+v"(pa[r][e]));
            }
        }
#pragma unroll
        for (int r = 0; r < RG; ++r) {
            const int t = gw + (ig + r) * NGW;
            float r8[8], r4[4], r2[2], r1;
#pragma unroll
            for (int e = 0; e < 8; ++e) { const bool up = (lane & 32) != 0; const float keep = up ? pa[r][e + 8] : pa[r][e], give = up ? pa[r][e] : pa[r][e + 8]; r8[e] = keep + __shfl_xor(give, 32); }
#pragma unroll
            for (int e = 0; e < 4; ++e) { const bool up = (lane & 16) != 0; const float keep = up ? r8[e + 4] : r8[e], give = up ? r8[e] : r8[e + 4]; r4[e] = keep + __shfl_xor(give, 16); }
#pragma unroll
            for (int e = 0; e < 2; ++e) { const bool up = (lane & 8) != 0; const float keep = up ? r4[e + 2] : r4[e], give = up ? r4[e] : r4[e + 2]; r2[e] = keep + __shfl_xor(give, 8); }
            { const bool up = (lane & 4) != 0; const float keep = up ? r2[1] : r2[0], give = up ? r2[0] : r2[1]; r1 = keep + __shfl_xor(give, 4); }
            r1 += __shfl_xor(r1, 2); r1 += __shfl_xor(r1, 1);
            const int eidx = ((lane >> 5) & 1) * 8 + ((lane >> 4) & 1) * 4 + ((lane >> 3) & 1) * 2 + ((lane >> 2) & 1);
            float mx = r1;
#pragma unroll
            for (int o = 4; o < 64; o <<= 1) mx = fmaxf(mx, __shfl_xor(mx, o));
            const float exv = expf(r1 - mx);
            float se = exv;
#pragma unroll
            for (int o = 4; o < 64; o <<= 1) se += __shfl_xor(se, o);
            { const int b = t / L, l = t % L; if ((lane & 3) == 0) aff[((size_t)b * NE + eidx) * L + l] = exv / se; }
        }
    }
    __syncthreads();
}

__device__ __forceinline__ void p6_topk_group(const P& p, LAS unsigned char* lds, int g, int tid, int lane, int wid) {
    LAS unsigned* cnt = (LAS unsigned*)lds; LAS unsigned* wsum = cnt + 8;
    const float* aff = (const float*)(p.ws + WS_AFF) + (size_t)g * L;
    unsigned v[8];
#pragma unroll
    for (int i = 0; i < 8; ++i) v[i] = __builtin_bit_cast(unsigned, aff[tid * 8 + i]);
    unsigned prefix = 0;
    for (int bit = 31; bit >= 0; --bit) {
        const unsigned cand = prefix | (1u << bit);
        unsigned c = 0;
#pragma unroll
        for (int i = 0; i < 8; ++i) c += (unsigned)__builtin_popcountll(__ballot(v[i] >= cand));
        LAS unsigned* cb = cnt + 16 + 8 * (bit & 1);
        if (lane == 0) cb[wid] = c;
        __syncthreads();
        unsigned tot = 0;
#pragma unroll
        for (int w = 0; w < 8; ++w) tot += cb[w];
        if (tot >= CAP) prefix = cand;
    }
    __syncthreads();
    unsigned ngt = 0, neq = 0;
#pragma unroll
    for (int i = 0; i < 8; ++i) { ngt += v[i] > prefix; neq += v[i] == prefix; }
    unsigned sg = ngt, se = neq;
#pragma unroll
    for (int o = 1; o < 64; o <<= 1) { const unsigned a = __shfl_up(sg, o), c = __shfl_up(se, o); if (lane >= o) { sg += a; se += c; } }
    if (lane == 63) { cnt[wid] = sg; wsum[wid] = se; }
    __syncthreads();
    unsigned og = 0, oe = 0, totg = 0;
#pragma unroll
    for (int w = 0; w < 8; ++w) { if (w < wid) { og += cnt[w]; oe += wsum[w]; } totg += cnt[w]; }
    unsigned pg = og + sg - ngt, pe = oe + se - neq;
    const unsigned need_eq = CAP - totg;
    int* stok = (int*)(p.ws + WS_SELTOK) + g * CAP; float* sgate = (float*)(p.ws + WS_SELGATE) + g * CAP;
    short* inv = (short*)(p.ws + WS_INV) + ((size_t)(g >> 4) * L + tid * 8) * NE + (g & 15);
#pragma unroll
    for (int i = 0; i < 8; ++i) {
        int slot = -1;
        if (v[i] > prefix) { slot = (int)pg; ++pg; }
        else if (v[i] == prefix) { if (pe < need_eq) slot = (int)(totg + pe); ++pe; }
        if (slot >= 0) { stok[slot] = (g >> 4) * L + tid * 8 + i; sgate[slot] = __builtin_bit_cast(float, v[i]); }
        inv[i * NE] = (short)slot;
    }
    __syncthreads();
}
__device__ __forceinline__ void p6_convert_experts(const P& p, LAS unsigned char* lds, int bx, int wave, int lane) {
    LAS float* scr = (LAS float*)(lds + 16384 + wave * 12288);
    constexpr int PER_E = 16 * 64 + 16 * 32, NIT = NE * PER_E, SHARE_A = 10, SHARE_B = 13;
    int it0, it1;
    if (bx < 64) { it0 = (bx * NWAVES + wave) * SHARE_A; it1 = it0 + SHARE_A; }
    else { it0 = 64 * NWAVES * SHARE_A + ((bx - 64) * NWAVES + wave) * SHARE_B; it1 = it0 + SHARE_B; }
    if (it1 > NIT) it1 = NIT;
    for (int it = it0; it < it1; ++it) {
        const int e = it / PER_E; int r = it % PER_E;
        if (r < 1024) { const int kb = r >> 6, nb = r & 63, rho = nb * 32, bj = (rho >> 7) & 1, f0 = (rho >> 8) * 128 + (rho & 127);
            transpose_item_fp8((bj ? p.wu : p.wg) + (size_t)e * D * EH, EH, D, (unsigned char*)(p.ws + (e < 8 ? WS_WGU0 : WS_WGU1)) + (size_t)(e & 7) * 2048 * D, kb * 64, rho, f0 + (lane & 31), 32.0f, scr, lane); }
        else { r -= 1024; const int kb = r >> 5, nb = r & 31;
            transpose_item_fp8(p.wd + (size_t)e * EH * D, D, EH, (unsigned char*)(p.ws + (e < 8 ? WS_WD0 : WS_WD1)) + (size_t)(e & 7) * D * EH, kb * 64, nb * 32, nb * 32 + (lane & 31), 32.0f, scr, lane); }
    }
}

__device__ __forceinline__ void p9_combine(const P& p, int gw, int NGW, int lane, bool havepre, const pg8::f32x4 (&pre)[4][4], const int (&preslot)[4]) {
    typedef float f32x2_9 __attribute__((ext_vector_type(2)));
    const short* inv = (const short*)(p.ws + WS_INV); const unsigned char* slab = (const unsigned char*)(p.ws + WS_SLAB);
    int nslot[4];
#pragma unroll
    for (int r = 0; r < 4; ++r) nslot[r] = havepre ? preslot[r] : ((lane < NE) ? (int)inv[(size_t)(gw * 4 + r) * NE + lane] : -1);
    for (int t0 = gw * 4; t0 < T; t0 += NGW * 4) {
        pg8::f32x4 a[4][4]; int myslot[4]; unsigned long long m[4];
        const bool usepre = havepre && t0 == gw * 4;
        const int tn = t0 + NGW * 4;
#pragma unroll
        for (int r = 0; r < 4; ++r) { myslot[r] = nslot[r];
            if (tn < T) nslot[r] = (lane < NE) ? (int)inv[(size_t)(tn + r) * NE + lane] : -1;
            const pg8::f32x4* orow = (const pg8::f32x4*)(p.out + (size_t)(t0 + r) * D) + lane * 4;
#pragma unroll
            for (int j = 0; j < 4; ++j) a[r][j] = usepre ? pre[r][j] : __builtin_nontemporal_load(orow + j); }
        const int b = t0 / L;
#pragma unroll
        for (int r = 0; r < 4; ++r) m[r] = __ballot(myslot[r] >= 0);
        while (m[0] | m[1] | m[2] | m[3]) {
            pg8::u32x4 s[4][3]; bool val[4][3];
#pragma unroll
            for (int r = 0; r < 4; ++r)
#pragma unroll
                for (int h = 0; h < 3; ++h) { val[r][h] = m[r] != 0;
                    if (val[r][h]) { const int e = __builtin_ctzll(m[r]); m[r] &= m[r] - 1;
                        const int slot = __shfl(myslot[r], e);
                        s[r][h] = __builtin_nontemporal_load((const pg8::u32x4*)(slab + ((size_t)(b * NE + e) * CAP + slot) * D) + lane); } }
#pragma unroll
            for (int r = 0; r < 4; ++r)
#pragma unroll
                for (int h = 0; h < 3; ++h) if (val[r][h]) {
#pragma unroll
                    for (int j = 0; j < 4; ++j) { const f32x2_9 lo = __builtin_amdgcn_cvt_pk_f32_fp8((int)s[r][h][j], false), hi = __builtin_amdgcn_cvt_pk_f32_fp8((int)s[r][h][j], true);
                        a[r][j] += (pg8::f32x4){lo[0], lo[1], hi[0], hi[1]}; } }
        }
#pragma unroll
        for (int r = 0; r < 4; ++r) { pg8::f32x4* orow = (pg8::f32x4*)(p.out + (size_t)(t0 + r) * D) + lane * 4;
#pragma unroll
            for (int j = 0; j < 4; ++j) orow[j] = a[r][j]; }
    }
}

__global__ void __launch_bounds__(NTHR, 2) mega(P p) {
    extern __shared__ __attribute__((aligned(16))) unsigned char lds_raw[];
    LAS unsigned char* lds = (LAS unsigned char*)lds_raw;
    const int tid = threadIdx.x, lane = tid & 63, wave = __builtin_amdgcn_readfirstlane(tid >> 6);
    const int G = gridDim.x, bx = blockIdx.x;
    const int vcu = (G % 8 == 0) ? (bx % 8) * (G / 8) + bx / 8 : bx;
    const int gw = vcu * NWAVES + wave, NGW = G * NWAVES, gt = bx * NTHR + tid, NGT = G * NTHR;
    unsigned char* ws = p.ws;
    if (tid < 64) ((LAS unsigned*)(lds + MISC_OFF))[tid] = 0u;
    __syncthreads();
    XcdBarrier xbar = xcd_barrier_post((unsigned*)(ws + WS_CTL) + CW_BAR, (volatile LAS unsigned*)(lds + MISC_OFF));
#define IN(k) (p.ph_lo <= (k) && (k) < p.ph_hi)
#if USE_XCD_BAR
#define SEAM(k) do { if (IN(k) && IN((k) + 1)) { if ((k) == CG_SEAM) cooperative_groups::this_grid().sync(); else xcd_barrier(xbar); } } while (0)
#else
#define SEAM(k) do { if (IN(k) && IN((k) + 1)) { cooperative_groups::this_grid().sync(); } } while (0)
#endif
    int m2i, lami;
    { const float m2v = static_max_log2(p), lamv = calc_lam(p); asm volatile("v_readfirstlane_b32 %0, %2\n\tv_readfirstlane_b32 %1, %3" : "=s"(m2i), "=s"(lami) : "v"(m2v), "v"(lamv)); }
    if (IN(0)) { p0_prologue(p, lds, gw, NGW, wave, lane, gt, NGT, 2); p0_prologue(p, lds, gw, NGW, wave, lane, gt, NGT, 13); }
#if PROBE_SUB
    if (IN(10)) p0_prologue(p, lds, gw, NGW, wave, lane, gt, NGT, PROBE_SUB);
#endif
    SEAM(0);
    if (IN(1)) {
        pg8::Gemm g{(const bf16*)(ws + WS_XB), (const bf16*)(ws + WS_WINT), (const bf16*)(ws + WS_WINT) + (size_t)3584 * D, (const bf16*)(ws + WS_XB), D};
        pg8::SchedP1 S{G, bx};
        pg8::EpiInProj E{(const float*)(ws + WS_RSTD1), (const float*)(ws + WS_ROPE), p.qng, p.kng, (bf16*)(ws + WS_QN), (bf16*)(ws + WS_KN), ws + WS_V, (bf16*)(ws + WS_HYT), ws + WS_GATES};
        pg8::gemm_phase<pg8::EpiInProj, pg8::SchedP1, true, true>(lds, g, S, E);
        p1_filter_taps(p, gw, NGW, opq_i(tid) & 63);
    }
    SEAM(1);
    if (IN(2)) {
        const float M2 = __builtin_bit_cast(float, m2i), lam = __builtin_bit_cast(float, lami);
        for (int rep = 0; rep < PROBE_ATT; ++rep)
        for (int uid = vcu; uid < 256; uid += G) { const int bh = uid >> 4, qb = uid & 15;
            attn::attn_unit(bh >> 2, bh & 3, qb, (const bf16*)(ws + WS_QN), (const bf16*)(ws + WS_KN), ws + WS_V, (bf16*)(ws + WS_ATTN), p.subln, M2, lam, lds, attn::WConv{p.wg, p.wu, p.wd, ws, uid}); }
#if FAST_LEVEL >= 5
        for (int rep = 0; rep < PROBE_HY; ++rep)
        { hy::Tw tw; hy::tw_init(tw, tid);
#pragma unroll 1
        for (int c = vcu; c < HW; c += G) hy::hyena_channel(p, c, lds, tid, tw); }
#endif
    }
    SEAM(2);
    if (IN(3)) {
        pg8::Gemm g{(const bf16*)(ws + WS_ATTN), (const bf16*)(ws + WS_WPA), (const bf16*)(ws + WS_HYENA), (const bf16*)(ws + WS_WPH), 512};
        pg8::SchedP3 S; S.so.init(T, D, G, bx);
        { pg8::Unit u0; S.so.next(0, u0); p3_transpose_panel(p, lds, u0.pm, u0.pn, wave, opq_i(tid) & 63);
          panel_rendezvous(xbar, (unsigned*)(ws + WS_CTL) + 10240 + 16 * u0.pm); }
        pg8::EpiMerge E{ws + WS_GATES, (bf16*)(ws + WS_TMPM), (bf16*)(ws + WS_MERGED)};
        pg8::gemm_phase<pg8::EpiMerge, pg8::SchedP3, true, true>(lds, g, S, E);
    }
    pg8::Unit u34; { pg8::StaticOrder S; S.init(T, D, G, bx); (void)S.next(0, u34); }
    if (IN(3) && IN(4)) panel_rendezvous(xbar, (unsigned*)(ws + WS_CTL) + 16 * u34.pm);
    if (IN(4)) {
        pg8::Gemm g{(const bf16*)(ws + WS_MERGED), (const bf16*)(ws + WS_WO), nullptr, nullptr, D};
        pg8::StaticOrder S; S.init(T, D, G, bx);
        if (u34.pn & 1) { pg8::EpiOutProjLate E{p.x, p.out}; pg8::gemm_phase<pg8::EpiOutProjLate, pg8::StaticOrder, true, true>(lds, g, S, E); }
        else { pg8::EpiOutProj E{p.x, p.out}; pg8::gemm_phase<pg8::EpiOutProj, pg8::StaticOrder, true, true>(lds, g, S, E); }
    }
    if (IN(4) && IN(5)) panel_rendezvous(xbar, (unsigned*)(ws + WS_CTL) + 2048 + 16 * u34.pm);
    if (IN(5)) p5_router(p, lds, u34.pm * 256 + u34.pn * 64 + wave, 8, tid, opq_i(tid) & 63);
    SEAM(5);
    if (IN(6)) {
        const int lane6 = opq_i(tid) & 63;
        if (bx < 64) p6_topk_group(p, lds, bx, tid, lane6, wave);
#if PROBE_SUB == 77
        p6_convert_experts(p, lds, bx, wave, lane6);
#endif
    }
    SEAM(6);
    if (IN(7)) {
        pg8::Gemm g{(const bf16*)(ws + WS_U2), (const bf16*)(ws + WS_WGU0), (const bf16*)(ws + WS_U2), (const bf16*)(ws + WS_WGU1 - 16 * MiB), D};
        pg8::SchedP7 S{G, bx};
        pg8::EpiGateUp E{(unsigned char*)(ws + WS_HBUF)};
        pg8::gemm_phase<pg8::EpiGateUp, pg8::SchedP7, true, true, true, true, 122, 127>(lds, g, S, E, (const int*)(ws + WS_SELTOK));
    }
    if (IN(7) && IN(8)) panel_rendezvous(xbar, (unsigned*)(ws + WS_CTL) + 8192 + 16 * ((bx & 7) * 8 + ((bx >> 3) & 7)));
    if (IN(8)) {
        pg8::Gemm g{(const bf16*)(ws + WS_HBUF), (const bf16*)(ws + WS_WD0), (const bf16*)(ws + WS_HBUF), (const bf16*)(ws + WS_WD1 - 8 * MiB), EH};
        pg8::SchedP8 S{G, bx};
        pg8::EpiDown E{(const float*)(ws + WS_SELGATE), ws + WS_SLAB};
        pg8::gemm_phase<pg8::EpiDown, pg8::SchedP8, true, true, false, true, 122, 127>(lds, g, S, E);
    }
    pg8::f32x4 pre9[4][4]; int preslot9[4] = {-1, -1, -1, -1}; bool havepre = false;
#pragma unroll
    for (int r = 0; r < 4; ++r)
#pragma unroll
        for (int j = 0; j < 4; ++j) pre9[r][j] = (pg8::f32x4){0.f, 0.f, 0.f, 0.f};
    if (IN(8) && IN(9)) {
        asm volatile("s_waitcnt vmcnt(0)" ::: "memory");
        __syncthreads();
        if (wave != 0) { havepre = true; const int l9 = opq_i(tid) & 63;
#pragma unroll
            for (int r = 0; r < 4; ++r) preslot9[r] = (l9 < NE) ? (int)((const short*)(ws + WS_INV))[(size_t)(gw * 4 + r) * NE + l9] : -1;
#pragma unroll
            for (int r = 0; r < 4; ++r) { const pg8::f32x4* orow = (const pg8::f32x4*)(p.out + (size_t)(gw * 4 + r) * D) + l9 * 4;
#pragma unroll
                for (int j = 0; j < 4; ++j) pre9[r][j] = __builtin_nontemporal_load(orow + j); } }
        xcd_barrier<true, true, false>(xbar);
    }
    if (IN(9)) p9_combine(p, gw, NGW, opq_i(tid) & 63, havepre, pre9, preslot9);
#undef IN
}

extern "C" void kernel_launch(void* const* d_in, const int* in_sizes, int n_in, void* d_out, int out_size, void* d_ws, size_t ws_size, hipStream_t stream) {
    static int ok = 0;
    if (ok == 0) {
        if (n_in != 29 || ws_size < WS_END) { fprintf(stderr, "kernel_launch: bad args n_in=%d ws=%zu\n", n_in, ws_size); ok = -1; return; }
        if (hipFuncSetAttribute((const void*)mega, hipFuncAttributeMaxDynamicSharedMemorySize, LDS_BYTES) != hipSuccess) { fprintf(stderr, "hipFuncSetAttribute failed\n"); ok = -1; return; }
        int dev = 0, cus = 0, per_cu = 0;
        (void)hipGetDevice(&dev); (void)hipDeviceGetAttribute(&cus, hipDeviceAttributeMultiprocessorCount, dev);
        (void)hipOccupancyMaxActiveBlocksPerMultiprocessor(&per_cu, (const void*)mega, NTHR, LDS_BYTES);
        if (cus * per_cu < 256) { fprintf(stderr, "kernel_launch: the 256-workgroup grid is not co-resident on this device (%d CUs x %d)\n", cus, per_cu); ok = -1; return; }
        ok = 1;
    }
    if (ok < 0) return;
    P p{};
    const float** f = (const float**)&p;
    for (int i = 0; i < 29; ++i) f[i] = (const float*)d_in[i];
    p.out = (float*)d_out; p.ws = (unsigned char*)d_ws;
    (void)hipMemsetAsync((char*)d_ws + WS_CTL, 0, 49152, stream);
#if ONE_LAUNCH
    p.ph_lo = 0; p.ph_hi = 10;
    { void* args[] = {&p}; hipError_t e = hipLaunchCooperativeKernel((const void*)mega, dim3(256), dim3(NTHR), args, LDS_BYTES, stream);
      if (e != hipSuccess) fprintf(stderr, "cooperative launch failed: %s\n", hipGetErrorString(e)); }
#else
#define MEGA(lo, hi) do { p.ph_lo = (lo); p.ph_hi = (hi); hipLaunchKernelGGL(mega, dim3(256), dim3(NTHR), LDS_BYTES, stream, p); } while (0)
    for (int k = 0; k < 10; ++k) { MEGA(k, k + 1); if (k == PROBE_DBL) MEGA(k, k + 1); }
    if (PROBE_DBL == 99) MEGA(99, 100);
#endif
}
```
